# Optimizing an MI355X kernel written in HIP

```python
import jax, jax.numpy as jnp
from jax import lax
import numpy as np

D_MODEL = 2048
BATCH = 4
SEQ = 4096
DEPTH = 2

D_ATTN = D_MODEL // 2
ATTN_HEAD_DIM = 64
N_Q_HEADS = D_ATTN // ATTN_HEAD_DIM
N_KV_HEADS = 4
WINDOW = 128
BLOCK = 128
ROPE_DIM = ATTN_HEAD_DIM // 4
ROPE_THETA = 500000.0

D_RET = D_MODEL - D_ATTN
RET_HEADS = 4
RET_HEAD_DIM = D_RET // RET_HEADS
RET_CHUNK = 128
RET_THETA = 10000.0

D_KV = N_KV_HEADS * ATTN_HEAD_DIM
D_IN = D_ATTN + 2 * D_KV + 4 * D_RET
D_MIX = D_ATTN + D_RET

D_FF = 5632
CONV_W = 3
EPS = 1e-6
NEG_INF = -1e30

kernel_name = "hymba_swa_sink_retention_convffn"


def _rms_norm(x, w):
    xf = x.astype(jnp.float32)
    y = xf * lax.rsqrt(jnp.mean(xf * xf, axis=-1, keepdims=True) + EPS)
    return (y * w.astype(jnp.float32)).astype(x.dtype)


def _rope(x, positions, rot_dim, theta):
    half = rot_dim // 2
    inv = jnp.power(jnp.float32(theta), -jnp.arange(half, dtype=jnp.float32) / half)
    ang = positions.astype(jnp.float32)[..., None] * inv
    cos = jnp.cos(ang)[:, :, None, :].astype(x.dtype)
    sin = jnp.sin(ang)[:, :, None, :].astype(x.dtype)
    x1 = x[..., :half]
    x2 = x[..., half:rot_dim]
    return jnp.concatenate([x1 * cos - x2 * sin, x2 * cos + x1 * sin, x[..., rot_dim:]], axis=-1)


def _swa_sink_attention(q, k, v, sinks):
    B, S, Hq, dh = q.shape
    Hkv = k.shape[2]
    G = Hq // Hkv
    nb = S // BLOCK
    qb = q.reshape(B, nb, BLOCK, Hkv, G, dh)

    def band(t):
        tp = jnp.pad(t, ((0, 0), (BLOCK, 0), (0, 0), (0, 0)))
        tb = tp.reshape(B, nb + 1, BLOCK, Hkv, dh)
        return jnp.concatenate([tb[:, :-1], tb[:, 1:]], axis=2)

    kb = band(k)
    vb = band(v)
    s = jnp.einsum('bnqhgd,bnkhd->bhgnqk', qb, kb).astype(jnp.float32) * (dh ** -0.5)
    qi = jnp.arange(BLOCK)[:, None]
    kj = jnp.arange(2 * BLOCK)[None, :]
    diff = BLOCK + qi - kj
    key_pos = jnp.arange(nb)[:, None, None] * BLOCK + kj[None] - BLOCK
    mask = ((diff >= 0) & (diff < WINDOW))[None] & (key_pos >= 0)
    s = jnp.where(mask, s, NEG_INF)
    sink = sinks.astype(jnp.float32).reshape(Hkv, G)[None, :, :, None, None, None]
    m = jnp.maximum(jnp.max(s, axis=-1, keepdims=True), sink)
    p = jnp.exp(s - m)
    denom = jnp.sum(p, axis=-1, keepdims=True) + jnp.exp(sink - m)
    p = (p / denom).astype(v.dtype)
    o = jnp.einsum('bhgnqk,bnkhd->bnqhgd', p, vb)
    return o.reshape(B, S, Hq * dh)


def _retention(q, k, v):
    B, S, H, d = q.shape
    dv = v.shape[-1]
    nc = S // RET_CHUNK
    q = q.astype(jnp.float32)
    k = k.astype(jnp.float32) * (d ** -0.5)
    v = v.astype(jnp.float32)
    lg = jnp.log(1.0 - jnp.power(2.0, -5.0 - jnp.arange(H, dtype=jnp.float32)))
    idx = jnp.arange(RET_CHUNK, dtype=jnp.float32)
    rel = idx[:, None] - idx[None, :]
    intra = jnp.where(rel >= 0, jnp.exp(lg[:, None, None] * jnp.maximum(rel, 0.0)), 0.0)
    q_dec = jnp.exp(lg[:, None] * (idx + 1.0))[..., None]
    k_dec = jnp.exp(lg[:, None] * (RET_CHUNK - 1.0 - idx))[..., None]
    chunk_dec = jnp.exp(lg * RET_CHUNK)[:, None, None]

    def to_chunks(t):
        return t.reshape(B, nc, RET_CHUNK, H, t.shape[-1]).transpose(1, 0, 3, 2, 4)

    def step(state, xs):
        qc, kc, vc = xs
        inner = jnp.einsum('bhij,bhjd->bhid', jnp.einsum('bhid,bhjd->bhij', qc, kc) * intra, vc)
        cross = jnp.einsum('bhid,bhde->bhie', qc * q_dec, state)
        state = state * chunk_dec + jnp.einsum('bhjd,bhje->bhde', kc * k_dec, vc)
        return state, inner + cross

    state0 = jnp.zeros((B, H, d, dv), jnp.float32)
    _, o = lax.scan(step, state0, (to_chunks(q), to_chunks(k), to_chunks(v)))
    return o.transpose(1, 0, 3, 2, 4).reshape(B, S, H, dv)


def _causal_dwconv(u, w, b):
    S = u.shape[1]
    up = jnp.pad(u, ((0, 0), (CONV_W - 1, 0), (0, 0)))
    y = b.astype(u.dtype)
    for kk in range(CONV_W):
        y = y + up[:, kk:kk + S] * w[kk]
    return y


def setup_inputs(seed: int = 0) -> dict:
    key = jax.random.key(seed)
    ks = jax.random.split(key, 16)
    f32 = jnp.float32
    x = jax.random.normal(ks[0], (BATCH, SEQ, D_MODEL), f32)
    positions = jnp.broadcast_to(jnp.arange(SEQ, dtype=jnp.int32), (BATCH, SEQ))
    w_in = jax.random.normal(ks[1], (DEPTH, D_MODEL, D_IN), f32) * D_MODEL ** -0.5
    w_out = jax.random.normal(ks[2], (DEPTH, D_MIX, D_MODEL), f32) * D_MIX ** -0.5
    w_up = jax.random.normal(ks[3], (DEPTH, D_MODEL, 2 * D_FF), f32) * D_MODEL ** -0.5
    w_down = jax.random.normal(ks[4], (DEPTH, D_FF, D_MODEL), f32) * D_FF ** -0.5
    conv_w = jax.random.normal(ks[5], (DEPTH, CONV_W, 2 * D_FF), f32) * CONV_W ** -0.5
    conv_b = jax.random.normal(ks[6], (DEPTH, 2 * D_FF), f32) * 0.02
    attn_sinks = jax.random.normal(ks[7], (DEPTH, N_Q_HEADS), f32) * 0.5
    def gain(k, shape):
        return 1.0 + 0.02 * jax.random.normal(k, shape, f32)
    pre_mix_norm = gain(ks[8], (DEPTH, D_MODEL))
    post_mix_norm = gain(ks[9], (DEPTH, D_MODEL))
    attn_out_norm = gain(ks[10], (DEPTH, D_ATTN))
    ret_out_norm = gain(ks[11], (DEPTH, RET_HEADS, RET_HEAD_DIM))
    pre_ffn_norm = gain(ks[12], (DEPTH, D_MODEL))
    post_ffn_norm = gain(ks[13], (DEPTH, D_MODEL))
    return {"x": x, "positions": positions, "w_in": w_in, "w_out": w_out,
            "w_up": w_up, "w_down": w_down, "conv_w": conv_w, "conv_b": conv_b,
            "attn_sinks": attn_sinks, "pre_mix_norm": pre_mix_norm,
            "post_mix_norm": post_mix_norm, "attn_out_norm": attn_out_norm,
            "ret_out_norm": ret_out_norm, "pre_ffn_norm": pre_ffn_norm,
            "post_ffn_norm": post_ffn_norm}


def reference(x, positions, w_in, w_out, w_up, w_down, conv_w, conv_b, attn_sinks,
              pre_mix_norm, post_mix_norm, attn_out_norm, ret_out_norm,
              pre_ffn_norm, post_ffn_norm):
    B, S, _ = x.shape
    split_at = [D_ATTN, D_ATTN + D_KV, D_ATTN + 2 * D_KV,
                D_ATTN + 2 * D_KV + D_RET, D_ATTN + 2 * D_KV + 2 * D_RET,
                D_ATTN + 2 * D_KV + 3 * D_RET]
    for l in range(DEPTH):
        h = _rms_norm(x, pre_mix_norm[l])
        proj = h @ w_in[l]
        qa, ka, va, qr, kr, vr, gr = jnp.split(proj, split_at, axis=-1)
        qa = _rope(qa.reshape(B, S, N_Q_HEADS, ATTN_HEAD_DIM), positions, ROPE_DIM, ROPE_THETA)
        ka = _rope(ka.reshape(B, S, N_KV_HEADS, ATTN_HEAD_DIM), positions, ROPE_DIM, ROPE_THETA)
        va = va.reshape(B, S, N_KV_HEADS, ATTN_HEAD_DIM)
        ya = _swa_sink_attention(qa, ka, va, attn_sinks[l])
        ya = _rms_norm(ya, attn_out_norm[l])
        qr = _rope(qr.reshape(B, S, RET_HEADS, RET_HEAD_DIM), positions, RET_HEAD_DIM, RET_THETA)
        kr = _rope(kr.reshape(B, S, RET_HEADS, RET_HEAD_DIM), positions, RET_HEAD_DIM, RET_THETA)
        vr = vr.reshape(B, S, RET_HEADS, RET_HEAD_DIM)
        yr = _rms_norm(_retention(qr, kr, vr), ret_out_norm[l]).astype(x.dtype)
        yr = yr.reshape(B, S, D_RET) * jax.nn.silu(gr)
        mix = jnp.concatenate([ya, yr], axis=-1) @ w_out[l]
        x = x + _rms_norm(mix, post_mix_norm[l])
        h = _rms_norm(x, pre_ffn_norm[l])
        u = _causal_dwconv(h @ w_up[l], conv_w[l], conv_b[l])
        a, g = jnp.split(u, 2, axis=-1)
        f = (jax.nn.gelu(a, approximate=True) * g) @ w_down[l]
        x = x + _rms_norm(f, post_ffn_norm[l])
    return x
```

```cpp
#include <hip/hip_runtime.h>
#include <hip/hip_cooperative_groups.h>
#include <cstdio>
namespace cg = cooperative_groups;

#ifndef MK_SINGLE
#define MK_SINGLE 1
#endif

#ifndef DBG_MASK
#define DBG_MASK 1023
#endif
#define LAS __attribute__((address_space(3)))
#define GAS __attribute__((address_space(1)))
typedef unsigned short bf16_t;
typedef short bf16x8 __attribute__((ext_vector_type(8)));
typedef short s16x4 __attribute__((ext_vector_type(4)));
typedef float f32x4 __attribute__((ext_vector_type(4)));
typedef float f32x16 __attribute__((ext_vector_type(16)));
typedef unsigned u32x4 __attribute__((ext_vector_type(4)));
typedef unsigned u32x2 __attribute__((ext_vector_type(2)));

constexpr int BATCH = 4, SEQ = 4096, DM = 2048, M = BATCH * SEQ, DIN = 5632, DFF = 5632, NUP = 11264, DEPTH = 2;
constexpr int C_QA = 0, C_KA = 1024, C_VA = 1280, C_QR = 1536, C_KR = 2560, C_VR = 3584, C_GR = 4608;
constexpr float EPS = 1e-6f;
constexpr int NTHREADS = 512, NWAVES = 8;
constexpr int LDS_BYTES = 147456;

constexpr size_t MiB = 1u << 20;
constexpr size_t SZ_WIN = (size_t)DIN * DM * 2, SZ_WOUT = (size_t)DM * DM * 2, SZ_WUP = (size_t)NUP * DM * 2, SZ_WDN = (size_t)DM * DFF * 2;
constexpr size_t WS_WIN = 1 * MiB;
constexpr size_t WS_WOUT = WS_WIN + 2 * SZ_WIN;
constexpr size_t WS_WUP = WS_WOUT + 2 * SZ_WOUT;
constexpr size_t WS_WDN = WS_WUP + 2 * SZ_WUP;
constexpr size_t WS_XN = WS_WDN + 2 * SZ_WDN;
constexpr size_t WS_BIG = WS_XN + (size_t)M * DM * 2;
constexpr size_t WS_MIXIN = WS_BIG + (size_t)M * DIN * 2;
constexpr size_t WS_YARAW = WS_MIXIN + (size_t)M * DM * 2;
constexpr size_t WS_STATE = WS_YARAW + (size_t)M * 1024 * 2;
constexpr size_t WS_ROPEA = WS_STATE + (size_t)BATCH * 4 * 32 * 65536 * 2;
constexpr size_t WS_ROPER = WS_ROPEA + (size_t)M * 16 * 4;
constexpr size_t WS_EDGE = WS_ROPER + (size_t)M * 256 * 4;
constexpr size_t WS_XR = WS_EDGE + (size_t)128 * 4 * NUP * 4;
constexpr size_t WS_END = WS_XR + (size_t)M * DM * 2;
static_assert((size_t)M * DM * 4 <= (size_t)M * DM * 2 + (size_t)M * 1024 * 2 + (size_t)BATCH * 4 * 32 * 65536 * 2, "MIX2 overlay");

__device__ __forceinline__ unsigned pk_bf16(float lo, float hi) {
    typedef float f32x2_t __attribute__((ext_vector_type(2)));
    typedef __bf16 bf16x2_t __attribute__((ext_vector_type(2)));
    f32x2_t v = {lo, hi}; bf16x2_t b = __builtin_convertvector(v, bf16x2_t);
    return __builtin_bit_cast(unsigned, b);
}
__device__ __forceinline__ float bf_lo(unsigned u) { return __uint_as_float(u << 16); }
__device__ __forceinline__ float bf_hi(unsigned u) { return __uint_as_float(u & 0xffff0000u); }
__device__ __forceinline__ float wave_sum(float v) {
#pragma unroll
    for (int o = 1; o < 64; o <<= 1) v += __shfl_xor(v, o);
    return v;
}
__device__ __forceinline__ int crow(int r, int h) { return (r & 3) + 8 * (r >> 2) + 4 * h; }
__device__ __forceinline__ bf16x8 pack8(const f32x16& x, int s) {
    u32x4 p;
    p[0] = pk_bf16(x[8 * s + 0], x[8 * s + 1]); p[1] = pk_bf16(x[8 * s + 2], x[8 * s + 3]);
    p[2] = pk_bf16(x[8 * s + 4], x[8 * s + 5]); p[3] = pk_bf16(x[8 * s + 6], x[8 * s + 7]);
    return __builtin_bit_cast(bf16x8, p);
}
#define MFMA32(a, b, c) __builtin_amdgcn_mfma_f32_32x32x16_bf16((a), (b), (c), 0, 0, 0)
__device__ __forceinline__ float gelu_tanh(float a) {
    const float u = a * (2.3022082f + 0.10294324f * a * a);
    return a * __builtin_amdgcn_rcpf(1.0f + __builtin_amdgcn_exp2f(-u));
}
__device__ __forceinline__ float silu_f(float x) { return x * __builtin_amdgcn_rcpf(1.0f + __builtin_amdgcn_exp2f(-1.4426950409f * x)); }

struct Args {
    const float* x; const int* pos; const float* w_in; const float* w_out; const float* w_up; const float* w_down;
    const float* conv_w; const float* conv_b; const float* sinks; const float* pre_mix; const float* post_mix;
    const float* attn_norm; const float* ret_norm; const float* pre_ffn; const float* post_ffn;
    float* out; unsigned char* ws; int ph_lo, ph_hi;
};

template <int CTRL> __device__ __forceinline__ float dpp_ror(float v) { return __builtin_bit_cast(float, __builtin_amdgcn_update_dpp(0, __builtin_bit_cast(int, v), CTRL, 0xf, 0xf, false)); }

namespace pg8 {
constexpr int BM = 256, BK = 64, HALF = 128, HTB = HALF * BK * 2, STAGE_BYTES = 8 * HTB, NXCD = 8, WGM = 8;
__device__ __forceinline__ int lds_byte(int r, int c) { const int st = (r >> 4) * 2 + (c >> 5), rr = r & 15, cc = c & 31, ob = rr * 64 + cc * 2; return st * 1024 + (ob ^ (((ob >> 9) & 1) << 5)); }
__device__ __forceinline__ void stage_rc(int b, int& R, int& C) { const int st = b / 1024, sb = b % 1024, swz = sb ^ (((sb >> 9) & 1) << 5); R = (st >> 1) * 16 + swz / 64; C = (st & 1) * 32 + (swz % 64) / 2; }
__device__ __forceinline__ int perm32(int rho) { const int n = rho >> 4, i = rho & 15; return 8 * (i >> 2) + 4 * n + (i & 3); }
struct Unit { int pm, pn; };
struct Gemm { const bf16_t* A; const bf16_t* Bt; int M, N, K; };
struct StaticOrder {
    int nM, nN, nwg, G, c;
    __device__ void init(int M_, int N_, int G_, int c_) { nM = M_ / BM; nN = N_ / BM; nwg = nM * nN; G = G_; c = c_; }
    __device__ bool next(int i, Unit& u) const {
        const long L = (long)i * G + c; if (L >= nwg) return false;
        int wgid = (int)L; { const int q = nwg / NXCD, r = nwg % NXCD, xcd = wgid % NXCD, off = wgid / NXCD; wgid = (xcd < r ? xcd * (q + 1) : r * (q + 1) + (xcd - r) * q) + off; }
        const int nig = WGM * nN, gid = wgid / nig, fm = gid * WGM, gsz = (nM - fm) < WGM ? (nM - fm) : WGM;
        u.pm = fm + ((wgid % nig) % gsz); u.pn = (wgid % nig) / gsz; return true;
    }
};

template <class Epi>
__device__ __forceinline__ void gemm_phase(LAS unsigned char* lds, const Gemm g, const StaticOrder& S, const Epi& E, const int tid) {
    const int wid = __builtin_amdgcn_readfirstlane(tid >> 6), lane = tid & 63, wr = wid >> 2, wc = wid & 3, fr = lane & 15, fq = lane >> 4;
    const int K = g.K, nt = K / BK;
    unsigned voffA[2], voffB[2];
#pragma unroll
    for (int i = 0; i < 2; ++i) { int R, C; stage_rc(tid * 16 + i * 8192, R, C); const int Rb = Epi::PERM ? ((R & ~31) + perm32(R & 31)) : R;
        const int Ra = Epi::AROWPERM ? (128 * (R >> 6) + 8 * (R & 15) + ((R >> 4) & 3)) : R;
        voffA[i] = (unsigned)(Ra * K + C) * 2u; voffB[i] = (unsigned)(Rb * K + C) * 2u; }
    const size_t kstep = (size_t)(BK * 2);
    const size_t hstepB = (size_t)HALF * K * 2;
    const size_t hstepA = Epi::AROWPERM ? (size_t)4 * K * 2 : (size_t)HALF * K * 2;
    const size_t tstep = (size_t)BM * K * 2;
    const unsigned ldsw = (unsigned)wid * 1024u;
    const int aoff = lds_byte(wr * 64 + fr, fq * 8), boff = lds_byte(wc * 32 + fr, fq * 8);
#define PG8_SA(b, h) (((b) * 2 + (h)) * HTB)
#define PG8_SB(b, h) ((4 + (b) * 2 + (h)) * HTB)
#define PG8_STAGE(bufoff, gbase, voff) do { _Pragma("unroll") for (int _i = 0; _i < 2; ++_i) \
        __builtin_amdgcn_global_load_lds((const unsigned*)((const char*)(gbase) + (voff)[_i]), (LAS unsigned*)(lds + (bufoff) + ldsw + _i * 8192), 16, 0, 0); } while (0)
#define PG8_LDA(dst, b, h) do { _Pragma("unroll") for (int m = 0; m < 4; ++m) _Pragma("unroll") for (int k = 0; k < 2; ++k) dst[m][k] = *(const LAS bf16x8*)(lds + PG8_SA(b, h) + aoff + m * 2048 + k * 1024); } while (0)
#define PG8_LDB(dst, b, h) do { _Pragma("unroll") for (int n = 0; n < 2; ++n) _Pragma("unroll") for (int k = 0; k < 2; ++k) dst[n][k] = *(const LAS bf16x8*)(lds + PG8_SB(b, h) + boff + n * 2048 + k * 1024); } while (0)
#define PG8_MMA(ai, bj, At, Bt) do { __builtin_amdgcn_s_setprio(1); _Pragma("unroll") for (int m = 0; m < 4; ++m) _Pragma("unroll") for (int n = 0; n < 2; ++n) _Pragma("unroll") for (int k = 0; k < 2; ++k) \
        acc[ai][bj][m][n] = __builtin_amdgcn_mfma_f32_16x16x32_bf16(Bt[n][k], At[m][k], acc[ai][bj][m][n], 0, 0, 0); __builtin_amdgcn_s_setprio(0); } while (0)
#define PG8_WAIT_V(n) asm volatile("s_waitcnt vmcnt(" #n ")" ::: "memory")
#define PG8_WAIT_L(n) asm volatile("s_waitcnt lgkmcnt(" #n ")" ::: "memory")
#define PG8_BAR __builtin_amdgcn_s_barrier()
#define PG8_SCHED __builtin_amdgcn_sched_barrier(0)
    Unit cur, nxt; int ui = 0;
    if (!S.next(0, cur)) return;
    f32x4 acc[2][2][4][2];
#pragma unroll
    for (int a = 0; a < 2; ++a)
#pragma unroll
        for (int b = 0; b < 2; ++b)
#pragma unroll
            for (int m = 0; m < 4; ++m)
#pragma unroll
                for (int n = 0; n < 2; ++n) acc[a][b][m][n] = (f32x4){0.f, 0.f, 0.f, 0.f};
    bf16x8 At[4][2], B0[2][2], B1[2][2];
    const char* cA = (const char*)g.A + (size_t)cur.pm * tstep; const char* cB = (const char*)g.Bt + (size_t)cur.pn * tstep;
    f32x4 pre = E.prefetch(cur, wc, lane);
    PG8_STAGE(PG8_SB(0, 0), cB, voffB); PG8_STAGE(PG8_SA(0, 0), cA, voffA); PG8_STAGE(PG8_SB(0, 1), cB + hstepB, voffB); PG8_STAGE(PG8_SA(0, 1), cA + hstepA, voffA);
    if (wr == 1) PG8_BAR;
    PG8_WAIT_V(4); PG8_BAR;
    PG8_STAGE(PG8_SB(1, 0), cB + kstep, voffB); PG8_STAGE(PG8_SA(1, 0), cA + kstep, voffA); PG8_STAGE(PG8_SB(1, 1), cB + hstepB + kstep, voffB);
    PG8_WAIT_V(6); PG8_BAR;
    for (;;) {
        const bool has_next = S.next(ui + 1, nxt);
        const char* nA = has_next ? (const char*)g.A + (size_t)nxt.pm * tstep : cA; const char* nB = has_next ? (const char*)g.Bt + (size_t)nxt.pn * tstep : cB;
        for (int t = 0; t < nt; t += 2) {
            const bool last = (t == nt - 2);
            const char* a1 = cA + (size_t)(t + 1) * kstep;
            const char* a2 = last ? nA : cA + (size_t)(t + 2) * kstep; const char* b2 = last ? nB : cB + (size_t)(t + 2) * kstep;
            const char* a3 = a2 + kstep; const char* b3 = b2 + kstep;
            PG8_LDB(B0, 0, 0); PG8_SCHED; PG8_LDA(At, 0, 0); PG8_STAGE(PG8_SA(1, 1), a1 + hstepA, voffA);
            PG8_WAIT_L(8); PG8_BAR; PG8_WAIT_L(0); PG8_MMA(0, 0, At, B0); PG8_BAR; PG8_SCHED;
            PG8_LDB(B1, 0, 1); PG8_STAGE(PG8_SB(0, 0), b2, voffB);
            PG8_BAR; PG8_WAIT_L(0); PG8_MMA(0, 1, At, B1); PG8_BAR;
            PG8_LDA(At, 0, 1); PG8_STAGE(PG8_SA(0, 0), a2, voffA);
            PG8_BAR; PG8_WAIT_L(0); PG8_MMA(1, 0, At, B0); PG8_BAR; PG8_SCHED;
            PG8_STAGE(PG8_SB(0, 1), b2 + hstepB, voffB);
            PG8_WAIT_V(6); PG8_BAR; PG8_MMA(1, 1, At, B1); PG8_BAR;
            PG8_LDB(B0, 1, 0); PG8_SCHED; PG8_LDA(At, 1, 0); PG8_STAGE(PG8_SA(0, 1), a2 + hstepA, voffA);
            PG8_WAIT_L(8); PG8_BAR; PG8_WAIT_L(0); PG8_MMA(0, 0, At, B0); PG8_BAR; PG8_SCHED;
            PG8_LDB(B1, 1, 1); PG8_STAGE(PG8_SB(1, 0), b3, voffB);
            PG8_BAR; PG8_WAIT_L(0); PG8_MMA(0, 1, At, B1); PG8_BAR;
            PG8_LDA(At, 1, 1); PG8_STAGE(PG8_SA(1, 0), a3, voffA);
            PG8_BAR; PG8_WAIT_L(0); PG8_MMA(1, 0, At, B0); PG8_BAR; PG8_SCHED;
            PG8_STAGE(PG8_SB(1, 1), b3 + hstepB, voffB);
            PG8_WAIT_V(6); PG8_BAR; PG8_MMA(1, 1, At, B1); PG8_BAR;
        }
        E(acc, cur, wr, wc, fr, fq, pre, lds);
        if (!has_next) break;
        pre = E.prefetch(nxt, wc, lane);
#pragma unroll
        for (int a = 0; a < 2; ++a)
#pragma unroll
            for (int b = 0; b < 2; ++b)
#pragma unroll
                for (int m = 0; m < 4; ++m)
#pragma unroll
                    for (int n = 0; n < 2; ++n) acc[a][b][m][n] = (f32x4){0.f, 0.f, 0.f, 0.f};
        cur = nxt; cA = nA; cB = nB; ++ui;
    }
    PG8_WAIT_V(0);
    if (wr == 0) PG8_BAR;
    PG8_BAR;
#undef PG8_SA
#undef PG8_SB
#undef PG8_STAGE
#undef PG8_LDA
#undef PG8_LDB
#undef PG8_MMA
#undef PG8_WAIT_V
#undef PG8_WAIT_L
#undef PG8_BAR
#undef PG8_SCHED
}

struct EpiF32 {
    static constexpr bool PERM = false, AROWPERM = false;
    float* C; int ldc;
    __device__ __forceinline__ f32x4 prefetch(const Unit&, int, int) const { return (f32x4){0.f, 0.f, 0.f, 0.f}; }
    __device__ __forceinline__ void operator()(const f32x4 (&acc)[2][2][4][2], const Unit& u, int wr, int wc, int fr, int fq, const f32x4&, LAS unsigned char*) const {
        const int row0 = u.pm * BM + wr * 64 + fr, col0 = u.pn * BM + wc * 32 + 4 * fq;
#pragma unroll
        for (int ai = 0; ai < 2; ++ai)
#pragma unroll
            for (int m = 0; m < 4; ++m) { float* rowp = C + (size_t)(row0 + ai * HALF + m * 16) * ldc + col0;
#pragma unroll
                for (int bj = 0; bj < 2; ++bj)
#pragma unroll
                    for (int n = 0; n < 2; ++n) *(f32x4*)(rowp + bj * HALF + n * 16) = acc[ai][bj][m][n]; }
    }
};

struct EpiBf16 {
    static constexpr bool PERM = true, AROWPERM = false;
    bf16_t* O; int ldc;
    __device__ __forceinline__ f32x4 prefetch(const Unit&, int, int) const { return (f32x4){0.f, 0.f, 0.f, 0.f}; }
    __device__ __forceinline__ void operator()(const f32x4 (&acc)[2][2][4][2], const Unit& u, int wr, int wc, int fr, int fq, const f32x4&, LAS unsigned char*) const {
        const int row0 = u.pm * BM + wr * 64 + fr, col0 = u.pn * BM + wc * 32 + 8 * fq;
#pragma unroll
        for (int ai = 0; ai < 2; ++ai)
#pragma unroll
            for (int m = 0; m < 4; ++m) { bf16_t* rowp = O + (size_t)(row0 + ai * HALF + m * 16) * ldc + col0;
#pragma unroll
                for (int bj = 0; bj < 2; ++bj) { const f32x4 v0 = acc[ai][bj][m][0], v1 = acc[ai][bj][m][1];
                    u32x4 w; w.x = pk_bf16(v0[0], v0[1]); w.y = pk_bf16(v0[2], v0[3]); w.z = pk_bf16(v1[0], v1[1]); w.w = pk_bf16(v1[2], v1[3]);
                    *(u32x4*)(rowp + bj * HALF) = w; } }
    }
};

struct EpiProj {
    static constexpr bool PERM = true, AROWPERM = false;
    bf16_t* O; const float* ropeA; const float* ropeR;
    __device__ __forceinline__ f32x4 prefetch(const Unit&, int, int) const { return (f32x4){0.f, 0.f, 0.f, 0.f}; }
    __device__ __forceinline__ void operator()(f32x4 (&acc)[2][2][4][2], const Unit& u, int wr, int wc, int fr, int fq, const f32x4&, LAS unsigned char*) const {
        const int pn = u.pn;
        const int rbase = u.pm * BM + wr * 64 + fr;
        const int cbase = pn * BM + wc * 32 + 8 * fq;
        if (pn <= 4) {
            const float sc = pn < 4 ? 0.125f : 1.0f;
            const bool ropew = (wc & 1) == 0;
#pragma unroll
            for (int ai = 0; ai < 2; ++ai)
#pragma unroll
                for (int m = 0; m < 4; ++m) {
                    const int row = rbase + ai * HALF + m * 16;
                    if (ropew) {
                        const f32x4* tp = (const f32x4*)(ropeA + (size_t)row * 16);
                        const f32x4 cs[2] = {tp[0], tp[1]}; const f32x4 sn[2] = {tp[2], tp[3]};
#pragma unroll
                        for (int bj = 0; bj < 2; ++bj)
#pragma unroll
                            for (int n = 0; n < 2; ++n)
#pragma unroll
                                for (int j = 0; j < 4; ++j) {
                                    const float own = acc[ai][bj][m][n][j]; const float par = __shfl_xor(own, 16);
                                    const float c = cs[n][j], s = sn[n][j];
                                    const float r0 = own * c - par * s, r1 = own * c + par * s;
                                    acc[ai][bj][m][n][j] = (fq == 0) ? r0 : ((fq == 1) ? r1 : own);
                                }
                    }
#pragma unroll
                    for (int bj = 0; bj < 2; ++bj) {
                        const f32x4 v0 = acc[ai][bj][m][0] * sc, v1 = acc[ai][bj][m][1] * sc;
                        u32x4 w; w.x = pk_bf16(v0[0], v0[1]); w.y = pk_bf16(v0[2], v0[3]); w.z = pk_bf16(v1[0], v1[1]); w.w = pk_bf16(v1[2], v1[3]);
                        *(u32x4*)(O + (size_t)row * DIN + cbase + bj * HALF) = w;
                    }
                }
        } else if (pn >= 6 && pn <= 13) {
            const int h = (pn - 6) & 3; const bool isK = pn >= 10;
            const float lg2 = __log2f(1.0f - exp2f(-5.0f - (float)h));
            const int i0 = wc * 32 + 8 * fq;
#pragma unroll
            for (int ai = 0; ai < 2; ++ai)
#pragma unroll
                for (int m = 0; m < 4; ++m) {
                    const int row = rbase + ai * HALF + m * 16;
                    const float p = (float)((row & 127) + 1);
                    const float dec = isK ? 0.0625f * exp2f(-p * lg2) : exp2f(p * lg2);
                    const f32x4* tc = (const f32x4*)(ropeR + (size_t)row * 256 + i0);
                    const f32x4* ts = (const f32x4*)(ropeR + (size_t)row * 256 + 128 + i0);
                    const f32x4 cs[2] = {tc[0], tc[1]}; const f32x4 sn[2] = {ts[0], ts[1]};
#pragma unroll
                    for (int n = 0; n < 2; ++n) {
                        const f32x4 x1 = acc[ai][0][m][n], x2 = acc[ai][1][m][n];
                        acc[ai][0][m][n] = (x1 * cs[n] - x2 * sn[n]) * dec;
                        acc[ai][1][m][n] = (x2 * cs[n] + x1 * sn[n]) * dec;
                    }
#pragma unroll
                    for (int bj = 0; bj < 2; ++bj) {
                        const f32x4 v0 = acc[ai][bj][m][0], v1 = acc[ai][bj][m][1];
                        u32x4 w; w.x = pk_bf16(v0[0], v0[1]); w.y = pk_bf16(v0[2], v0[3]); w.z = pk_bf16(v1[0], v1[1]); w.w = pk_bf16(v1[2], v1[3]);
                        *(u32x4*)(O + (size_t)row * DIN + cbase + bj * HALF) = w;
                    }
                }
        } else {
            const bool gate = pn >= 18;
#pragma unroll
            for (int ai = 0; ai < 2; ++ai)
#pragma unroll
                for (int m = 0; m < 4; ++m) {
                    const int row = rbase + ai * HALF + m * 16;
#pragma unroll
                    for (int bj = 0; bj < 2; ++bj) {
                        f32x4 v0 = acc[ai][bj][m][0], v1 = acc[ai][bj][m][1];
                        if (gate) {
#pragma unroll
                            for (int j = 0; j < 4; ++j) { v0[j] = silu_f(v0[j]); v1[j] = silu_f(v1[j]); }
                        }
                        u32x4 w; w.x = pk_bf16(v0[0], v0[1]); w.y = pk_bf16(v0[2], v0[3]); w.z = pk_bf16(v1[0], v1[1]); w.w = pk_bf16(v1[2], v1[3]);
                        *(u32x4*)(O + (size_t)row * DIN + cbase + bj * HALF) = w;
                    }
                }
        }
    }
};

struct EpiUpConv {
    static constexpr bool PERM = true, AROWPERM = true;
    bf16_t* ACT; float* EDGE; const float* cw; const float* cb;
    __device__ __forceinline__ f32x4 prefetch(const Unit& u, int wc, int lane) const {
        const int k = lane >> 4, part = (lane >> 3) & 1, c = 4 * (lane & 7);
        const float* p = (k < 3 ? cw + (size_t)k * NUP : cb) + part * DFF + u.pn * 128 + wc * 32 + c;
        return *(const f32x4*)p;
    }
    __device__ __forceinline__ void operator()(const f32x4 (&acc)[2][2][4][2], const Unit& u, int wr, int wc, int fr, int fq, const f32x4& pre, LAS unsigned char* lds) const {
        const int lane = fq * 16 + fr;
        LAS float* wl = (LAS float*)(lds + STAGE_BYTES + (wr * 4 + wc) * 1024);
        *(LAS f32x4*)(wl + 4 * lane) = pre;
        const int rowh = u.pm * BM + wr * HALF;
        const int hidx = rowh >> 7;
#pragma unroll
        for (int n = 0; n < 2; ++n) {
            const int ca = u.pn * 128 + wc * 32 + 8 * fq + 4 * n;
            const LAS float* wq = wl + 8 * fq + 4 * n;
            const f32x4 wa0 = *(const LAS f32x4*)(wq), wa1 = *(const LAS f32x4*)(wq + 64), wa2 = *(const LAS f32x4*)(wq + 128), ba = *(const LAS f32x4*)(wq + 192);
            const f32x4 wg0 = *(const LAS f32x4*)(wq + 32), wg1 = *(const LAS f32x4*)(wq + 96), wg2 = *(const LAS f32x4*)(wq + 160), bg = *(const LAS f32x4*)(wq + 224);
            const f32x4 a6 = acc[1][0][2][n], a7 = acc[1][0][3][n], g6 = acc[1][1][2][n], g7 = acc[1][1][3][n];
            f32x4 pa6, pa7, pg6, pg7;
#pragma unroll
            for (int j = 0; j < 4; ++j) { pa6[j] = dpp_ror<0x121>(a6[j]); pa7[j] = dpp_ror<0x121>(a7[j]); pg6[j] = dpp_ror<0x121>(g6[j]); pg7[j] = dpp_ror<0x121>(g7[j]); }
#pragma unroll
            for (int gi = 0; gi < 8; ++gi) {
                const f32x4 a = acc[gi >> 2][0][gi & 3][n], g = acc[gi >> 2][1][gi & 3][n];
                const f32x4 am1 = gi >= 1 ? acc[(gi - 1 + 8) % 8 >> 2][0][(gi - 1 + 8) % 8 & 3][n] : pa7;
                const f32x4 gm1 = gi >= 1 ? acc[(gi - 1 + 8) % 8 >> 2][1][(gi - 1 + 8) % 8 & 3][n] : pg7;
                const f32x4 am2 = gi >= 2 ? acc[(gi - 2 + 8) % 8 >> 2][0][(gi - 2 + 8) % 8 & 3][n] : (gi == 1 ? pa7 : pa6);
                const f32x4 gm2 = gi >= 2 ? acc[(gi - 2 + 8) % 8 >> 2][1][(gi - 2 + 8) % 8 & 3][n] : (gi == 1 ? pg7 : pg6);
                const f32x4 ua = wa0 * am2 + wa1 * am1 + wa2 * a + ba;
                const f32x4 ug = wg0 * gm2 + wg1 * gm1 + wg2 * g + bg;
                const int row = rowh + 8 * fr + gi;
                if (!(gi < 2 && fr == 0)) {
                    u32x2 w; w.x = pk_bf16(gelu_tanh(ua[0]) * ug[0], gelu_tanh(ua[1]) * ug[1]); w.y = pk_bf16(gelu_tanh(ua[2]) * ug[2], gelu_tanh(ua[3]) * ug[3]);
                    *(u32x2*)(ACT + (size_t)row * DFF + ca) = w;
                }
                if (gi < 2 && fr == 0) { float* e = EDGE + (size_t)(hidx * 4 + gi) * NUP; *(f32x4*)(e + ca) = a; *(f32x4*)(e + DFF + ca) = g; }
                if (gi >= 6 && fr == 15) { float* e = EDGE + (size_t)(hidx * 4 + gi - 4) * NUP; *(f32x4*)(e + ca) = a; *(f32x4*)(e + DFF + ca) = g; }
            }
        }
    }
};
}

typedef const Args __attribute__((address_space(4)))* KArgs;
struct Frame {
    LAS unsigned char* lds;
    int tid, lane, wave, G, bid;
    KArgs ka;
    GAS unsigned char* ws;
};
#define WSP(T, off) ((T*)(F.ws + (off)))
#define P_WinT  WSP(bf16_t, WS_WIN)
#define P_WoutT WSP(bf16_t, WS_WOUT)
#define P_WupT  WSP(bf16_t, WS_WUP)
#define P_WdnT  WSP(bf16_t, WS_WDN)
#define P_XN    WSP(bf16_t, WS_XN)
#define P_PROJ  WSP(bf16_t, WS_BIG)
#define P_ACT   WSP(bf16_t, WS_BIG)
#define P_MIX   WSP(float, WS_BIG)
#define P_MIXB  WSP(bf16_t, WS_BIG)
#define P_MIX2B WSP(bf16_t, WS_MIXIN)
#define P_MIXIN WSP(bf16_t, WS_MIXIN)
#define P_MIX2  WSP(float, WS_MIXIN)
#define P_YARAW WSP(bf16_t, WS_YARAW)
#define P_STATE WSP(bf16_t, WS_STATE)
#define P_ROPEA WSP(float, WS_ROPEA)
#define P_ROPER WSP(float, WS_ROPER)
#define P_EDGE  WSP(float, WS_EDGE)
#define P_XR    WSP(bf16_t, WS_XR)

__device__ __forceinline__ void transpose_item(const float* W, int K, int N, bf16_t* WT, int k0, int n0, int drow0, LAS float* scr, int lane) {
#pragma unroll 8
    for (int i = 0; i < 64; ++i) scr[i * 65 + lane] = W[(size_t)(k0 + i) * N + n0 + lane];
    asm volatile("s_waitcnt lgkmcnt(0)" ::: "memory");
    const int c = lane & 7;
#pragma unroll
    for (int j = 0; j < 8; ++j) { const int n = (lane >> 3) + 8 * j; const LAS float* s = scr + (8 * c) * 65 + n;
        u32x4 o; o.x = pk_bf16(s[0 * 65], s[1 * 65]); o.y = pk_bf16(s[2 * 65], s[3 * 65]); o.z = pk_bf16(s[4 * 65], s[5 * 65]); o.w = pk_bf16(s[6 * 65], s[7 * 65]);
        *(u32x4*)(WT + (size_t)(drow0 + n) * K + k0 + 8 * c) = o; }
    asm volatile("s_waitcnt lgkmcnt(0)" ::: "memory");
}
__device__ __forceinline__ void p0_prologue(Frame& F) {
    LAS float* scr = (LAS float*)(F.lds + F.wave * 16640);
    const int gw = F.bid * NWAVES + F.wave, NGW = F.G * NWAVES;
    constexpr int I_IN = (DM / 64) * (DIN / 64), I_OUT = (DM / 64) * (DM / 64), I_UP = (DM / 64) * (NUP / 64), I_DN = (DFF / 64) * (DM / 64);
    constexpr int PER_L = I_IN + I_OUT + I_UP + I_DN;
    for (int it = gw; it < DEPTH * PER_L; it += NGW) {
        const int l = it / PER_L; int r = it % PER_L;
        if (r < I_IN) { const int nb = DIN / 64, kb = r / nb, n0 = 64 * (r % nb); transpose_item(((const float*)(GAS const float*)F.ka->w_in) + (size_t)l * DM * DIN, DM, DIN, P_WinT + (size_t)l * DIN * DM, 64 * kb, n0, n0, scr, F.lane); continue; } r -= I_IN;
        if (r < I_OUT) { const int nb = DM / 64, kb = r / nb, n0 = 64 * (r % nb); transpose_item(((const float*)(GAS const float*)F.ka->w_out) + (size_t)l * DM * DM, DM, DM, P_WoutT + (size_t)l * DM * DM, 64 * kb, n0, n0, scr, F.lane); continue; } r -= I_OUT;
        if (r < I_UP) { const int nb = NUP / 64, kb = r / nb, n0 = 64 * (r % nb);
            const int bj = n0 >= DFF ? 1 : 0, cc = n0 - bj * DFF, drow = 256 * (cc >> 7) + 128 * bj + (cc & 127);
            transpose_item(((const float*)(GAS const float*)F.ka->w_up) + (size_t)l * DM * NUP, DM, NUP, P_WupT + (size_t)l * NUP * DM, 64 * kb, n0, drow, scr, F.lane); continue; } r -= I_UP;
        { const int nb = DM / 64, kb = r / nb, n0 = 64 * (r % nb); transpose_item(((const float*)(GAS const float*)F.ka->w_down) + (size_t)l * DFF * DM, DFF, DM, P_WdnT + (size_t)l * DM * DFF, 64 * kb, n0, n0, scr, F.lane); }
    }
    const int gt = F.bid * NTHREADS + F.tid, NGT = F.G * NTHREADS;
    for (int i = gt; i < M * 8; i += NGT) { const int m = i >> 3, f = i & 7;
        const float inv = powf(500000.0f, -(float)f / 8.0f);
        const double rev = (double)((const int*)(GAS const int*)F.ka->pos)[m] * (double)inv * 0.15915494309189535; const float fr = (float)(rev - floor(rev));
        P_ROPEA[(size_t)m * 16 + f] = __builtin_amdgcn_cosf(fr); P_ROPEA[(size_t)m * 16 + 8 + f] = __builtin_amdgcn_sinf(fr); }
    for (int i = gt; i < M * 128; i += NGT) { const int m = i >> 7, f = i & 127;
        const float inv = powf(10000.0f, -(float)f / 128.0f);
        const double rev = (double)((const int*)(GAS const int*)F.ka->pos)[m] * (double)inv * 0.15915494309189535; const float fr = (float)(rev - floor(rev));
        P_ROPER[(size_t)m * 256 + f] = __builtin_amdgcn_cosf(fr); P_ROPER[(size_t)m * 256 + 128 + f] = __builtin_amdgcn_sinf(fr); }
    for (int m = gw; m < M; m += NGW) {
        const f32x4* xr = (const f32x4*)(((const float*)(GAS const float*)F.ka->x) + (size_t)m * DM) + F.lane; f32x4 v[8]; float ss = 0.f;
#pragma unroll
        for (int j = 0; j < 8; ++j) { v[j] = xr[64 * j]; ss += (v[j].x * v[j].x + v[j].y * v[j].y) + (v[j].z * v[j].z + v[j].w * v[j].w); }
        const float rs = rsqrtf(wave_sum(ss) * (1.0f / DM) + EPS);
        u32x2* o = (u32x2*)(P_XN + (size_t)m * DM) + F.lane; const f32x4* wn = (const f32x4*)((const float*)(GAS const float*)F.ka->pre_mix) + F.lane;
#pragma unroll
        for (int j = 0; j < 8; ++j) { const f32x4 w = wn[64 * j]; u32x2 p; p.x = pk_bf16(v[j].x * rs * w.x, v[j].y * rs * w.y); p.y = pk_bf16(v[j].z * rs * w.z, v[j].w * rs * w.w); o[64 * j] = p; }
    }
}

template <bool XI_F32, bool XO_F32>
__device__ __forceinline__ void rowpass(Frame& F, const void* xi_, const bf16_t* mix, const float* wpost, const float* wnext, void* xo_, bool do_xn) {
    const int gw = F.bid * NWAVES + F.wave, NGW = F.G * NWAVES;
    u32x4 mv[4]; f32x4 xv[4][2];
    auto ldx = [&](int m, int j, f32x4& a, f32x4& b2) {
        const int c8 = 8 * (F.lane + 64 * j);
        if (XI_F32) { const float* p = (const float*)xi_ + (size_t)m * DM + c8; a = __builtin_nontemporal_load((const f32x4*)p); b2 = __builtin_nontemporal_load((const f32x4*)(p + 4)); }
        else { const u32x4 r = __builtin_nontemporal_load((const u32x4*)((const bf16_t*)xi_ + (size_t)m * DM + c8));
               a = (f32x4){bf_lo(r.x), bf_hi(r.x), bf_lo(r.y), bf_hi(r.y)}; b2 = (f32x4){bf_lo(r.z), bf_hi(r.z), bf_lo(r.w), bf_hi(r.w)}; }
    };
    f32x4 wpv[4][2], wnv[4][2];
#pragma unroll
    for (int j = 0; j < 4; ++j) { const int c8 = 8 * (F.lane + 64 * j); wpv[j][0] = *(const f32x4*)(wpost + c8); wpv[j][1] = *(const f32x4*)(wpost + c8 + 4); wnv[j][0] = *(const f32x4*)(wnext + c8); wnv[j][1] = *(const f32x4*)(wnext + c8 + 4); }
    int m = gw;
    if (m < M) {
#pragma unroll
        for (int j = 0; j < 4; ++j) { mv[j] = __builtin_nontemporal_load((const u32x4*)(mix + (size_t)m * DM + 8 * (F.lane + 64 * j))); ldx(m, j, xv[j][0], xv[j][1]); }
    }
    while (m < M) {
        const int mn = m + NGW;
        u32x4 nmv[4]; f32x4 nxv[4][2];
        if (mn < M) {
#pragma unroll
            for (int j = 0; j < 4; ++j) { nmv[j] = __builtin_nontemporal_load((const u32x4*)(mix + (size_t)mn * DM + 8 * (F.lane + 64 * j))); ldx(mn, j, nxv[j][0], nxv[j][1]); }
        } else {
#pragma unroll
            for (int j = 0; j < 4; ++j) { nmv[j] = mv[j]; nxv[j][0] = xv[j][0]; nxv[j][1] = xv[j][1]; }
        }
        f32x4 v[4][2]; float ss = 0.f;
#pragma unroll
        for (int j = 0; j < 4; ++j) {
            v[j][0] = (f32x4){bf_lo(mv[j].x), bf_hi(mv[j].x), bf_lo(mv[j].y), bf_hi(mv[j].y)}; v[j][1] = (f32x4){bf_lo(mv[j].z), bf_hi(mv[j].z), bf_lo(mv[j].w), bf_hi(mv[j].w)};
#pragma unroll
            for (int q = 0; q < 2; ++q) ss += (v[j][q].x * v[j][q].x + v[j][q].y * v[j][q].y) + (v[j][q].z * v[j][q].z + v[j][q].w * v[j][q].w);
        }
        const float rs = rsqrtf(wave_sum(ss) * (1.0f / DM) + EPS);
        float s2 = 0.f;
#pragma unroll
        for (int j = 0; j < 4; ++j) { const int c8 = 8 * (F.lane + 64 * j);
#pragma unroll
            for (int q = 0; q < 2; ++q) { const f32x4 y = xv[j][q] + v[j][q] * rs * wpv[j][q]; v[j][q] = y;
                s2 += (y.x * y.x + y.y * y.y) + (y.z * y.z + y.w * y.w); }
            if (XO_F32) { float* p = (float*)xo_ + (size_t)m * DM + c8; __builtin_nontemporal_store(v[j][0], (f32x4*)p); __builtin_nontemporal_store(v[j][1], (f32x4*)(p + 4)); }
            else { u32x4 p; p.x = pk_bf16(v[j][0].x, v[j][0].y); p.y = pk_bf16(v[j][0].z, v[j][0].w); p.z = pk_bf16(v[j][1].x, v[j][1].y); p.w = pk_bf16(v[j][1].z, v[j][1].w);
                   *(u32x4*)((bf16_t*)xo_ + (size_t)m * DM + c8) = p; }
        }
        if (do_xn) {
            const float rs2 = rsqrtf(wave_sum(s2) * (1.0f / DM) + EPS);
#pragma unroll
            for (int j = 0; j < 4; ++j) { const int c8 = 8 * (F.lane + 64 * j); const f32x4 w0 = wnv[j][0], w1 = wnv[j][1];
                u32x4 p; p.x = pk_bf16(v[j][0].x * rs2 * w0.x, v[j][0].y * rs2 * w0.y); p.y = pk_bf16(v[j][0].z * rs2 * w0.z, v[j][0].w * rs2 * w0.w);
                p.z = pk_bf16(v[j][1].x * rs2 * w1.x, v[j][1].y * rs2 * w1.y); p.w = pk_bf16(v[j][1].z * rs2 * w1.z, v[j][1].w * rs2 * w1.w);
                *(u32x4*)(P_XN + (size_t)m * DM + c8) = p; }
        }
#pragma unroll
        for (int j = 0; j < 4; ++j) { mv[j] = nmv[j]; xv[j][0] = nxv[j][0]; xv[j][1] = nxv[j][1]; }
        m = mn;
    }
}

typedef short v4i16_t __attribute__((ext_vector_type(4)));
__device__ __forceinline__ s16x4 vtr(const LAS unsigned char* p) { return __builtin_bit_cast(s16x4, __builtin_amdgcn_ds_read_tr16_b64_v4i16((LAS v4i16_t*)p)); }
__device__ __forceinline__ bf16x8 vtr8(const LAS unsigned char* lo, const LAS unsigned char* hi) { const s16x4 a = vtr(lo), b = vtr(hi); return __builtin_shufflevector(a, b, 0, 1, 2, 3, 4, 5, 6, 7); }

constexpr int AT_KPB = 144, AT_VPB = 192;
constexpr int AT_V_OFF = 256 * AT_KPB;
__device__ __forceinline__ void attn_load(Frame& F, int unit, u32x4 (&kv)[4], u32x4 (&vv)[4]) {
    const int b = unit >> 7, nb = (unit >> 2) & 31, kvh = unit & 3;
    const int tokc = b * SEQ + nb * 128;
#pragma unroll
    for (int i = 0; i < 4; ++i) {
        const int p = F.tid + NTHREADS * i, row = p >> 3, ch = p & 7;
        const bool valid = (nb > 0) || (row >= 128);
        kv[i] = (u32x4){0u, 0u, 0u, 0u}; vv[i] = (u32x4){0u, 0u, 0u, 0u};
        if (valid) { const bf16_t* src = P_PROJ + (size_t)(tokc - 128 + row) * DIN + 64 * kvh + 8 * ch; kv[i] = *(const u32x4*)(src + C_KA); vv[i] = *(const u32x4*)(src + C_VA); }
    }
}
__device__ __forceinline__ void attn_qload(Frame& F, int unit, int pp, int lane, bf16x8 (&Q)[4]) {
    const int b = unit >> 7, nb = (unit >> 2) & 31, kvh = unit & 3, pass = F.wave + 8 * pp, g = pass >> 2, c = pass & 3, hq = 4 * kvh + g;
    const bf16_t* qp = P_PROJ + (size_t)(b * SEQ + nb * 128 + 32 * c + (lane & 31)) * DIN + C_QA + 64 * hq + 8 * (lane >> 5);
#pragma unroll
    for (int ks = 0; ks < 4; ++ks) Q[ks] = *(const bf16x8*)(qp + 16 * ks);
}
__device__ __forceinline__ void attn_units(Frame& F, int l, int first, int stride) {
    LAS unsigned char* Ks = F.lds; LAS unsigned char* Vs = F.lds + AT_V_OFF;
    u32x4 kv[4], vv[4]; bf16x8 Qn[4];
    if (first < 512) { attn_load(F, first, kv, vv); attn_qload(F, first, 0, F.lane, Qn); }
#pragma unroll 1
  for (int unit = first; unit < 512; unit += stride) {
    int lane_ = F.lane; asm volatile("" : "+v"(lane_));
    const int lane = lane_, r32 = lane & 31, h2 = lane >> 5, tid = F.wave * 64 + lane;
    const int trq = (lane & 15) >> 2, trc = 16 * ((lane >> 4) & 1) + 4 * (lane & 3);
    const int b = unit >> 7, nb = (unit >> 2) & 31, kvh = unit & 3;
    const int tokc = b * SEQ + nb * 128;
    __syncthreads();
#pragma unroll
    for (int i = 0; i < 4; ++i) {
        const int p = tid + NTHREADS * i, row = p >> 3, ch = p & 7;
        *(LAS u32x4*)(Ks + row * AT_KPB + 16 * ch) = kv[i];
        *(LAS u32x4*)(Vs + row * AT_VPB + 16 * ch) = vv[i];
    }
    __syncthreads();
#pragma unroll 1
    for (int pp = 0; pp < 2; ++pp) {
        const int pass = F.wave + 8 * pp, g = pass >> 2, c = pass & 3, hq = 4 * kvh + g;
        const int qrow = tokc + 32 * c + r32;
        bf16x8 Qf[4];
#pragma unroll
        for (int ks = 0; ks < 4; ++ks) Qf[ks] = Qn[ks];
        if (pp == 0) { attn_qload(F, unit, 1, lane, Qn); if (unit + stride < 512) attn_load(F, unit + stride, kv, vv); }
        else if (unit + stride < 512) attn_qload(F, unit + stride, 0, lane, Qn);
        f32x16 s[5];
#pragma unroll
        for (int t = 0; t < 5; ++t) {
#pragma unroll
            for (int r = 0; r < 16; ++r) s[t][r] = 0.f;
#pragma unroll
            for (int ks = 0; ks < 4; ++ks) { const bf16x8 kf = *(const LAS bf16x8*)(Ks + (32 * (c + t) + r32) * AT_KPB + (16 * ks + 8 * h2) * 2); s[t] = MFMA32(kf, Qf[ks], s[t]); }
            __builtin_amdgcn_sched_barrier(0);
        }
        const float sink = ((const float*)(GAS const float*)F.ka->sinks)[l * 16 + hq];
        float mx = sink;
#pragma unroll
        for (int t = 0; t < 5; ++t) {
            const bool tile_ok = (nb > 0) || (c + t >= 4);
#pragma unroll
            for (int r = 0; r < 16; ++r) {
                float v = s[t][r];
                if (t == 0) v = (crow(r, h2) > r32) ? v : -1e30f;
                if (t == 4) v = (crow(r, h2) <= r32) ? v : -1e30f;
                v = tile_ok ? v : -1e30f;
                s[t][r] = v; mx = fmaxf(mx, v);
            }
        }
        mx = fmaxf(mx, __shfl_xor(mx, 32));
        float sum = 0.f;
#pragma unroll
        for (int t = 0; t < 5; ++t)
#pragma unroll
            for (int r = 0; r < 16; ++r) { const float p = __expf(s[t][r] - mx); s[t][r] = p; sum += p; }
        sum += __shfl_xor(sum, 32);
        __builtin_amdgcn_sched_barrier(0);
        const float inv = 1.0f / (sum + __expf(sink - mx));
        f32x16 o[2];
#pragma unroll
        for (int db = 0; db < 2; ++db)
#pragma unroll
            for (int r = 0; r < 16; ++r) o[db][r] = 0.f;
#pragma unroll
        for (int t = 0; t < 5; ++t) {
#pragma unroll
            for (int r = 0; r < 16; ++r) s[t][r] *= inv;
#pragma unroll
            for (int sk = 0; sk < 2; ++sk) {
                const bf16x8 pb = pack8(s[t], sk);
#pragma unroll
                for (int db = 0; db < 2; ++db) {
                    const LAS unsigned char* vp = Vs + (32 * (c + t) + 16 * sk + 4 * h2 + trq) * AT_VPB + (32 * db + trc) * 2;
                    const bf16x8 va = vtr8(vp, vp + 8 * AT_VPB);
                    o[db] = MFMA32(va, pb, o[db]);
                }
            }
            __builtin_amdgcn_sched_barrier(0);
        }
#pragma unroll
        for (int db = 0; db < 2; ++db)
#pragma unroll
            for (int rq = 0; rq < 4; ++rq) { const int d0 = 32 * db + 8 * rq + 4 * h2;
                u32x2 w; w.x = pk_bf16(o[db][4 * rq], o[db][4 * rq + 1]); w.y = pk_bf16(o[db][4 * rq + 2], o[db][4 * rq + 3]);
                *(u32x2*)(P_YARAW + (size_t)qrow * 1024 + 64 * hq + d0) = w; }
    }
  }
}

constexpr int RS_KPB = 576, RS_VPB = 64;
constexpr int RS_V_OFF = 128 * RS_KPB;
__device__ __forceinline__ void ret_scan_task(Frame& F, int task) {
    const int b = task >> 5, h = (task >> 3) & 3, e = task & 7;
    LAS unsigned char* Kt = F.lds; LAS unsigned char* Vs = F.lds + RS_V_OFF;
    const int lane = F.lane, r32 = lane & 31, h2 = lane >> 5, w = F.wave;
    const int trq = (lane & 15) >> 2, trc = 16 * ((lane >> 4) & 1) + 4 * (lane & 3);
    const float lg2 = __log2f(1.0f - exp2f(-5.0f - (float)h));
    const float g128 = exp2f(128.0f * lg2);
    f32x16 st;
#pragma unroll
    for (int r = 0; r < 16; ++r) st[r] = 0.f;
    u32x4 kA[8], vA, kB[8], vB;
    const bf16_t* kbase = P_PROJ + (size_t)(b * SEQ) * DIN + C_KR + 256 * h;
    const bf16_t* vbase = P_PROJ + (size_t)(b * SEQ) * DIN + C_VR + 256 * h + 32 * e;
#define RS_LOAD(KR, VR, cc) do { const size_t adv_ = (size_t)(128 * (cc)) * DIN; \
        _Pragma("unroll") for (int i = 0; i < 8; ++i) { const int p = tid_ + NTHREADS * i; KR[i] = *(const u32x4*)(kbase + adv_ + (size_t)(p >> 5) * DIN + 8 * (p & 31)); } \
        VR = *(const u32x4*)(vbase + adv_ + (size_t)(tid_ >> 2) * DIN + 8 * (tid_ & 3)); } while (0)
#define RS_STEP(KR, VR, cc) do { \
        __syncthreads(); \
        _Pragma("unroll") for (int i = 0; i < 8; ++i) { const int p = tid_ + NTHREADS * i; *(LAS u32x4*)(Kt + (p >> 5) * RS_KPB + 16 * (p & 31)) = KR[i]; } \
        *(LAS u32x4*)(Vs + (tid_ >> 2) * RS_VPB + 16 * (tid_ & 3)) = VR; \
        { bf16_t* sp = P_STATE + ((size_t)((b * 4 + h) * 32 + (cc))) * 65536 + 32 * w + r32_; \
          _Pragma("unroll") for (int r = 0; r < 16; ++r) sp[(size_t)(32 * e + crow(r, h2_)) * 256] = (bf16_t)(pk_bf16(st[r], 0.f) & 0xffffu); } \
        __syncthreads(); \
        if ((cc) + 2 < 32) RS_LOAD(KR, VR, (cc) + 2); \
        _Pragma("unroll") for (int ks = 0; ks < 8; ++ks) { \
            const LAS unsigned char* ap = Vs + (16 * ks + 8 * h2_ + trq_) * RS_VPB + trc_ * 2; \
            const LAS unsigned char* bp = Kt + (16 * ks + 8 * h2_ + trq_) * RS_KPB + (32 * w + trc_) * 2; \
            const bf16x8 af = vtr8(ap, ap + 4 * RS_VPB); const bf16x8 bfr = vtr8(bp, bp + 4 * RS_KPB); \
            st = MFMA32(af, bfr, st); } \
        _Pragma("unroll") for (int r = 0; r < 16; ++r) st[r] *= g128; } while (0)
    { const int tid_ = F.tid; RS_LOAD(kA, vA, 0); RS_LOAD(kB, vB, 1); }
#pragma unroll 1
    for (int c = 0; c < 32; c += 2) {
        int tid_ = F.tid; asm volatile("" : "+v"(tid_));
        const int l_ = tid_ & 63, r32_ = l_ & 31, h2_ = l_ >> 5, trq_ = (l_ & 15) >> 2, trc_ = 16 * ((l_ >> 4) & 1) + 4 * (l_ & 3);
        RS_STEP(kA, vA, c); RS_STEP(kB, vB, c + 1);
    }
#undef RS_LOAD
#undef RS_STEP
}

constexpr int RO_KPB = 528, RO_VPB = 576;
constexpr int RO_V_OFF = 128 * RO_KPB;
constexpr int RO_RED_OFF = RO_V_OFF + 128 * RO_VPB;
__device__ __forceinline__ void ret_out_task(Frame& F, int l, int task) {
    const int b = task >> 7, h = (task >> 5) & 3, c = task & 31;
    const int tok0 = b * SEQ + 128 * c;
    LAS unsigned char* Kc = F.lds; LAS unsigned char* Vs = F.lds + RO_V_OFF; LAS float* red = (LAS float*)(F.lds + RO_RED_OFF);
    int lane_ = F.lane; asm volatile("" : "+v"(lane_));
    const int lane = lane_, r32 = lane & 31, h2 = lane >> 5, w = F.wave, ib = w & 3, hv = w >> 2;
    const int trq = (lane & 15) >> 2, trc = 16 * ((lane >> 4) & 1) + 4 * (lane & 3);
    __syncthreads();
    {
        const unsigned char* sg = (const unsigned char*)(P_STATE + ((size_t)((b * 4 + h) * 32 + c)) * 65536);
#pragma unroll 1
        for (int i = 0; i < 16; ++i) {
            const int k = w + 8 * i, row = 2 * k + (lane >> 5), ch = (lane & 31) ^ (row & 31);
            __builtin_amdgcn_global_load_lds((const unsigned*)(sg + (size_t)row * 512 + ch * 16), (LAS unsigned*)(F.lds + k * 1024), 16, 0, 0);
        }
    }
    const bf16_t* qrow = P_PROJ + (size_t)(tok0 + 32 * ib + r32) * DIN + C_QR + 256 * h + 8 * h2;
    bf16x8 Qf[16];
#pragma unroll
    for (int ks = 0; ks < 16; ++ks) Qf[ks] = *(const bf16x8*)(qrow + 16 * ks);
    asm volatile("s_waitcnt vmcnt(0)" ::: "memory");
    __syncthreads();
    __builtin_amdgcn_sched_barrier(0);
    u32x4 kreg[8], vreg[8];
#pragma unroll
    for (int i = 0; i < 8; ++i) { const int p = (w * 64 + lane) + NTHREADS * i, row = p >> 5, ch = p & 31;
        const bf16_t* src = P_PROJ + (size_t)(tok0 + row) * DIN + 256 * h + 8 * ch;
        kreg[i] = *(const u32x4*)(src + C_KR); vreg[i] = *(const u32x4*)(src + C_VR); }
    __builtin_amdgcn_sched_barrier(0);
    f32x16 o[4];
#pragma unroll
    for (int t = 0; t < 4; ++t)
#pragma unroll
        for (int r = 0; r < 16; ++r) o[t][r] = 0.f;
#pragma unroll
    for (int ks = 0; ks < 16; ++ks) {
#pragma unroll
        for (int t = 0; t < 4; ++t) { const bf16x8 sa = *(const LAS bf16x8*)(F.lds + (128 * hv + 32 * t + r32) * 512 + (((2 * ks + h2) ^ r32) * 16)); o[t] = MFMA32(sa, Qf[ks], o[t]); }
        __builtin_amdgcn_sched_barrier(0);
    }
    __builtin_amdgcn_sched_barrier(0);
    __syncthreads();
#pragma unroll
    for (int i = 0; i < 8; ++i) { const int p = (w * 64 + lane) + NTHREADS * i, row = p >> 5, ch = p & 31;
        *(LAS u32x4*)(Kc + row * RO_KPB + 16 * ch) = kreg[i];
        *(LAS u32x4*)(Vs + row * RO_VPB + 16 * ch) = vreg[i]; }
    __syncthreads();
    __builtin_amdgcn_sched_barrier(0);
#pragma unroll
    for (int jb = 0; jb < 4; ++jb) if (jb <= ib) {
        f32x16 sA, sB;
#pragma unroll
        for (int r = 0; r < 16; ++r) { sA[r] = 0.f; sB[r] = 0.f; }
#pragma unroll
        for (int ks = 0; ks < 16; ks += 2) {
            const bf16x8 k0 = *(const LAS bf16x8*)(Kc + (32 * jb + r32) * RO_KPB + (16 * ks + 8 * h2) * 2);
            const bf16x8 k1 = *(const LAS bf16x8*)(Kc + (32 * jb + r32) * RO_KPB + (16 * (ks + 1) + 8 * h2) * 2);
            sA = MFMA32(k0, Qf[ks], sA); sB = MFMA32(k1, Qf[ks + 1], sB);
            __builtin_amdgcn_sched_barrier(0);
        }
#pragma unroll
        for (int r = 0; r < 16; ++r) { sA[r] += sB[r]; if (jb == ib && crow(r, h2) > r32) sA[r] = 0.f; }
#pragma unroll
        for (int sk = 0; sk < 2; ++sk) {
            const bf16x8 pb = pack8(sA, sk);
#pragma unroll
            for (int t = 0; t < 4; ++t) {
                const LAS unsigned char* vp = Vs + (32 * jb + 16 * sk + 4 * h2 + trq) * RO_VPB + (128 * hv + 32 * t + trc) * 2;
                const bf16x8 va = vtr8(vp, vp + 8 * RO_VPB);
                o[t] = MFMA32(va, pb, o[t]);
            }
        }
        __builtin_amdgcn_sched_barrier(0);
    }
    float ss = 0.f;
#pragma unroll
    for (int t = 0; t < 4; ++t)
#pragma unroll
        for (int r = 0; r < 16; ++r) ss += o[t][r] * o[t][r];
    ss += __shfl_xor(ss, 32);
    if (lane < 32) red[w * 32 + lane] = ss;
    __syncthreads();
    const float tot = red[w * 32 + r32] + red[(w ^ 4) * 32 + r32];
    const float rs = rsqrtf(tot * (1.0f / 256.0f) + EPS);
    const int tok = tok0 + 32 * ib + r32;
#pragma unroll
    for (int t = 0; t < 4; ++t)
#pragma unroll
        for (int rq = 0; rq < 4; ++rq) {
            const int dv0 = 128 * hv + 32 * t + 8 * rq + 4 * h2;
            const u32x2 gt = *(const u32x2*)(P_PROJ + (size_t)tok * DIN + C_GR + 256 * h + dv0);
            const f32x4 wn = *(const f32x4*)(((const float*)(GAS const float*)F.ka->ret_norm) + (size_t)l * 1024 + 256 * h + dv0);
            const float y0 = o[t][4 * rq] * rs * wn[0] * bf_lo(gt.x), y1 = o[t][4 * rq + 1] * rs * wn[1] * bf_hi(gt.x);
            const float y2 = o[t][4 * rq + 2] * rs * wn[2] * bf_lo(gt.y), y3 = o[t][4 * rq + 3] * rs * wn[3] * bf_hi(gt.y);
            u32x2 wv; wv.x = pk_bf16(y0, y1); wv.y = pk_bf16(y2, y3);
            *(u32x2*)(P_MIXIN + (size_t)tok * DM + 1024 + 256 * h + dv0) = wv;
        }
}

__device__ __forceinline__ void attn_norm_rows(Frame& F, int l) {
    const int gw = F.bid * NWAVES + F.wave, NGW = F.G * NWAVES;
    const f32x4* wn = (const f32x4*)(((const float*)(GAS const float*)F.ka->attn_norm) + (size_t)l * 1024);
    f32x4 wv[2][2];
#pragma unroll
    for (int j = 0; j < 2; ++j) { const int col = 8 * (F.lane + 64 * j); wv[j][0] = wn[col / 4]; wv[j][1] = wn[col / 4 + 1]; }
    for (int m0 = gw; m0 < M; m0 += 4 * NGW) {
        u32x4 v[4][2];
#pragma unroll
        for (int i = 0; i < 4; ++i) { const int m = m0 + i * NGW; if (m < M) { const u32x4* src = (const u32x4*)(P_YARAW + (size_t)m * 1024) + F.lane; v[i][0] = src[0]; v[i][1] = src[64]; } else { v[i][0] = (u32x4){0u, 0u, 0u, 0u}; v[i][1] = v[i][0]; } }
#pragma unroll
        for (int i = 0; i < 4; ++i) {
            const int m = m0 + i * NGW;
            float f[16]; float ss = 0.f;
#pragma unroll
            for (int j = 0; j < 2; ++j)
#pragma unroll
                for (int q = 0; q < 4; ++q) { f[8 * j + 2 * q] = bf_lo(v[i][j][q]); f[8 * j + 2 * q + 1] = bf_hi(v[i][j][q]); }
#pragma unroll
            for (int q = 0; q < 16; ++q) ss += f[q] * f[q];
            const float rs = rsqrtf(wave_sum(ss) * (1.0f / 1024.0f) + EPS);
            if (m < M) {
#pragma unroll
                for (int j = 0; j < 2; ++j) { const int col = 8 * (F.lane + 64 * j); const f32x4 w0 = wv[j][0], w1 = wv[j][1];
                    u32x4 o; o.x = pk_bf16(f[8 * j] * rs * w0[0], f[8 * j + 1] * rs * w0[1]); o.y = pk_bf16(f[8 * j + 2] * rs * w0[2], f[8 * j + 3] * rs * w0[3]);
                    o.z = pk_bf16(f[8 * j + 4] * rs * w1[0], f[8 * j + 5] * rs * w1[1]); o.w = pk_bf16(f[8 * j + 6] * rs * w1[2], f[8 * j + 7] * rs * w1[3]);
                    *(u32x4*)(P_MIXIN + (size_t)m * DM + col) = o; }
            }
        }
    }
}

__device__ __forceinline__ void conv_fixup(Frame& F, int l) {
    const float* cw = ((const float*)(GAS const float*)F.ka->conv_w) + (size_t)l * 3 * NUP; const float* cb = ((const float*)(GAS const float*)F.ka->conv_b) + (size_t)l * NUP;
    const int gt = F.bid * NTHREADS + F.tid, NGT = F.G * NTHREADS;
    constexpr int CG = DFF / 4;
    for (int idx = gt; idx < 128 * 2 * CG; idx += NGT) {
        const int cg4 = idx % CG, r = (idx / CG) & 1, hi = idx / (2 * CG);
        const int ca = 4 * cg4; const bool hasprev = (hi & 31) != 0;
        const f32x4 z = {0.f, 0.f, 0.f, 0.f};
        const float* e0 = P_EDGE + (size_t)(hi * 4) * NUP; const float* ep = P_EDGE + (size_t)((hi - 1) * 4) * NUP;
        f32x4 a0, a1, a2, g0, g1, g2;
        if (r == 0) {
            a2 = *(const f32x4*)(e0 + ca); g2 = *(const f32x4*)(e0 + DFF + ca);
            a1 = hasprev ? *(const f32x4*)(ep + 3 * NUP + ca) : z; g1 = hasprev ? *(const f32x4*)(ep + 3 * NUP + DFF + ca) : z;
            a0 = hasprev ? *(const f32x4*)(ep + 2 * NUP + ca) : z; g0 = hasprev ? *(const f32x4*)(ep + 2 * NUP + DFF + ca) : z;
        } else {
            a2 = *(const f32x4*)(e0 + NUP + ca); g2 = *(const f32x4*)(e0 + NUP + DFF + ca);
            a1 = *(const f32x4*)(e0 + ca); g1 = *(const f32x4*)(e0 + DFF + ca);
            a0 = hasprev ? *(const f32x4*)(ep + 3 * NUP + ca) : z; g0 = hasprev ? *(const f32x4*)(ep + 3 * NUP + DFF + ca) : z;
        }
        const f32x4 ua = *(const f32x4*)(cw + ca) * a0 + *(const f32x4*)(cw + NUP + ca) * a1 + *(const f32x4*)(cw + 2 * NUP + ca) * a2 + *(const f32x4*)(cb + ca);
        const f32x4 ug = *(const f32x4*)(cw + DFF + ca) * g0 + *(const f32x4*)(cw + NUP + DFF + ca) * g1 + *(const f32x4*)(cw + 2 * NUP + DFF + ca) * g2 + *(const f32x4*)(cb + DFF + ca);
        u32x2 w; w.x = pk_bf16(gelu_tanh(ua[0]) * ug[0], gelu_tanh(ua[1]) * ug[1]); w.y = pk_bf16(gelu_tanh(ua[2]) * ug[2], gelu_tanh(ua[3]) * ug[3]);
        *(u32x2*)(P_ACT + (size_t)(128 * hi + r) * DFF + ca) = w;
    }
}


#define XB_TMO      128
#define XB_XCNT(j)  (256  + 64 * (j))
#define XB_XSUB(j)  (1280 + 64 * (j))
#define XB_XGEN(j)  (2304 + 64 * (j))
#define XB_TOP      3328
#define XB_TOPGEN   3392
#define XCD_BAR_WORDS 3456
#define XB_SPIN_CAP (1u << 18)
__device__ __forceinline__ unsigned xb_ld(unsigned* p)              { return __hip_atomic_load(p, __ATOMIC_RELAXED, __HIP_MEMORY_SCOPE_AGENT); }
__device__ __forceinline__ unsigned xb_add(unsigned* p, unsigned v) { return __hip_atomic_fetch_add(p, v, __ATOMIC_RELAXED, __HIP_MEMORY_SCOPE_AGENT); }
__device__ __forceinline__ unsigned xb_xcc_id() { return (unsigned)__builtin_amdgcn_s_getreg((3 << 11) | 20) & 0xFu; }
#define XB_SPIN(cond, bar) do { unsigned _sp = 0; while (cond) { __builtin_amdgcn_s_sleep(1); \
    if ((++_sp & 255u) == 0u) { if (xb_ld(&(bar)[XB_TMO])) break; if (_sp > XB_SPIN_CAP) { atomicAdd(&(bar)[XB_TMO], 1u); break; } } } } while (0)
struct XcdBarrier { unsigned* bar; unsigned x; volatile LAS unsigned* st; };
__device__ __forceinline__ XcdBarrier xcd_barrier_post(unsigned* bar, volatile LAS unsigned* st) {
    XcdBarrier b; b.bar = bar; b.x = xb_xcc_id(); b.st = st;
    if (threadIdx.x == 0) (void)xb_add(&bar[XB_XCNT(b.x)], 1u);
    return b;
}
__device__ __forceinline__ void xcd_barrier_complete(unsigned* bar, unsigned x, unsigned& nloc, unsigned& nx) {
    const unsigned G = gridDim.x * gridDim.y * gridDim.z;
    unsigned sum, cnt, mine, sp = 0u;
    for (;;) {
        sum = 0u; cnt = 0u; mine = 0u;
#pragma unroll
        for (unsigned j = 0; j < 16; ++j) { const unsigned c = xb_ld(&bar[XB_XCNT(j)]); sum += c; cnt += (c > 0u) ? 1u : 0u; mine = (j == x) ? c : mine; }
        if (sum == G) break;
        __builtin_amdgcn_s_sleep(1);
        if ((++sp & 255u) == 0u) { if (xb_ld(&bar[XB_TMO])) break; if (sp > XB_SPIN_CAP) { atomicAdd(&bar[XB_TMO], 1u); break; } }
    }
    nloc = mine > 0u ? mine : 1u; nx = cnt > 0u ? cnt : 1u;
}
__device__ __forceinline__ void xcd_barrier(const XcdBarrier& b) {
    asm volatile("s_waitcnt vmcnt(0)" ::: "memory");
    __syncthreads();
    if (threadIdx.x == 0) {
        unsigned* bar = b.bar;
        __builtin_amdgcn_s_waitcnt(0);
        unsigned nloc = b.st[0], nx = b.st[1];
        if (nloc == 0u) { xcd_barrier_complete(bar, b.x, nloc, nx); b.st[0] = nloc; b.st[1] = nx; }
        const unsigned old = xb_add(&bar[XB_XSUB(b.x)], 1u);
        const unsigned gen = old / nloc;
        if (old + 1u == (gen + 1u) * nloc) {
            __builtin_amdgcn_fence(__ATOMIC_RELEASE, "agent");
            asm volatile("s_waitcnt vmcnt(0)" ::: "memory");
            const unsigned og = xb_add(&bar[XB_TOP], 1u);
            const unsigned tg = og / nx;
            if (og + 1u == (tg + 1u) * nx) xb_add(&bar[XB_TOPGEN], 1u);
            else XB_SPIN(xb_ld(&bar[XB_TOPGEN]) == tg, bar);
            __builtin_amdgcn_fence(__ATOMIC_ACQUIRE, "agent");
            xb_add(&bar[XB_XGEN(b.x)], 1u);
            asm volatile("s_waitcnt vmcnt(0)" ::: "memory");
        } else {
            XB_SPIN(xb_ld(&bar[XB_XGEN(b.x)]) == gen, bar);
            __builtin_amdgcn_fence(__ATOMIC_ACQUIRE, "agent");
            asm volatile("s_waitcnt vmcnt(0)" ::: "memory");
        }
    }
    __syncthreads();
}
constexpr int LDS_BARW_OFF = LDS_BYTES - 64;

constexpr int NPHASES = 1 + DEPTH * 9;
__global__ void __launch_bounds__(NTHREADS, 2) fwd_kernel(Args args) {
    extern __shared__ __attribute__((aligned(16))) unsigned char lds_raw[];
    Frame F;
    F.lds = (LAS unsigned char*)lds_raw;
    F.tid = threadIdx.x; F.lane = F.tid & 63; F.wave = __builtin_amdgcn_readfirstlane(F.tid >> 6);
    F.G = gridDim.x; F.bid = blockIdx.x; F.ka = (KArgs)__builtin_amdgcn_kernarg_segment_ptr();
    F.ws = (GAS unsigned char*)F.ka->ws;

    if (threadIdx.x < 16) ((LAS unsigned*)(F.lds + LDS_BARW_OFF))[threadIdx.x] = 0u;
    __syncthreads();
    const XcdBarrier xbar = xcd_barrier_post((unsigned*)(GAS unsigned*)F.ka->ws, (volatile LAS unsigned*)(F.lds + LDS_BARW_OFF));
    const int ph_hi = F.ka->ph_hi;
    for (int ph = F.ka->ph_lo; ph < ph_hi; ++ph) {
        { int t_ = threadIdx.x; asm volatile("" : "+v"(t_)); F.tid = t_; F.lane = t_ & 63; F.wave = __builtin_amdgcn_readfirstlane(t_ >> 6);
          int b_ = blockIdx.x; asm volatile("" : "+s"(b_)); F.bid = b_; int g_ = gridDim.x; asm volatile("" : "+s"(g_)); F.G = g_;
          unsigned long long w_ = (unsigned long long)F.ka->ws; asm volatile("" : "+s"(w_)); F.ws = (GAS unsigned char*)w_;
          unsigned l_ = (unsigned)(size_t)lds_raw; asm volatile("" : "+s"(l_)); F.lds = (LAS unsigned char*)(size_t)l_; }
        if (ph == 0) {
            if (DBG_MASK & 1) p0_prologue(F);
        } else {
            const int l = (ph - 1) / 9, sp = (ph - 1) % 9;
            if (sp == 0 && (DBG_MASK & 2)) {
                pg8::Gemm g{P_XN, P_WinT + (size_t)l * DIN * DM, M, DIN, DM}; pg8::StaticOrder S; S.init(M, DIN, F.G, F.bid);
                pg8::EpiProj E{P_PROJ, P_ROPEA, P_ROPER};
                pg8::gemm_phase<pg8::EpiProj>(F.lds, g, S, E, F.tid);
            } else if (sp == 1 && (DBG_MASK & 4)) {
                if (F.G >= 256) {
                    if (F.bid < 128) ret_scan_task(F, F.bid);
                    else attn_units(F, l, F.bid - 128, F.G - 128);
                } else {
                    for (int t = F.bid; t < 128 + 512; t += F.G) { if (t < 128) ret_scan_task(F, t); else attn_units(F, l, t - 128, 512); }
                }
            } else if (sp == 2 && (DBG_MASK & 8)) {
                for (int t = F.bid; t < 512; t += F.G) ret_out_task(F, l, t);
                attn_norm_rows(F, l);
            } else if (sp == 3 && (DBG_MASK & 16)) {
                pg8::Gemm g{P_MIXIN, P_WoutT + (size_t)l * DM * DM, M, DM, DM}; pg8::StaticOrder S; S.init(M, DM, F.G, F.bid);
                pg8::EpiBf16 E{P_MIXB, DM};
                pg8::gemm_phase<pg8::EpiBf16>(F.lds, g, S, E, F.tid);
            } else if (sp == 4 && (DBG_MASK & 32)) {
                if (l == 0) rowpass<true, false>(F, ((const float*)(GAS const float*)F.ka->x), P_MIXB, ((const float*)(GAS const float*)F.ka->post_mix), ((const float*)(GAS const float*)F.ka->pre_ffn), P_XR, true);
                else rowpass<false, false>(F, P_XR, P_MIXB, ((const float*)(GAS const float*)F.ka->post_mix) + (size_t)l * DM, ((const float*)(GAS const float*)F.ka->pre_ffn) + (size_t)l * DM, P_XR, true);
            } else if (sp == 5 && (DBG_MASK & 64)) {
                pg8::Gemm g{P_XN, P_WupT + (size_t)l * NUP * DM, M, NUP, DM}; pg8::StaticOrder S; S.init(M, NUP, F.G, F.bid);
                pg8::EpiUpConv E{P_ACT, P_EDGE, ((const float*)(GAS const float*)F.ka->conv_w) + (size_t)l * 3 * NUP, ((const float*)(GAS const float*)F.ka->conv_b) + (size_t)l * NUP};
                pg8::gemm_phase<pg8::EpiUpConv>(F.lds, g, S, E, F.tid);
            } else if (sp == 6 && (DBG_MASK & 128)) {
                conv_fixup(F, l);
            } else if (sp == 7 && (DBG_MASK & 256)) {
                pg8::Gemm g{P_ACT, P_WdnT + (size_t)l * DM * DFF, M, DM, DFF}; pg8::StaticOrder S; S.init(M, DM, F.G, F.bid);
                pg8::EpiBf16 E{P_MIX2B, DM};
                pg8::gemm_phase<pg8::EpiBf16>(F.lds, g, S, E, F.tid);
            } else if (sp == 8 && (DBG_MASK & 512)) {
                if (l + 1 < DEPTH) rowpass<false, false>(F, P_XR, P_MIX2B, ((const float*)(GAS const float*)F.ka->post_ffn) + (size_t)l * DM, ((const float*)(GAS const float*)F.ka->pre_mix) + (size_t)(l + 1) * DM, P_XR, true);
                else rowpass<false, true>(F, P_XR, P_MIX2B, ((const float*)(GAS const float*)F.ka->post_ffn) + (size_t)l * DM, ((const float*)(GAS const float*)F.ka->pre_mix), ((float*)(GAS float*)F.ka->out), false);
            }
        }
        if (ph + 1 < ph_hi) {
            if (ph_hi > NPHASES) { __syncthreads(); cg::this_grid().sync(); }
            else xcd_barrier(xbar);
        }
    }
}

extern "C" void kernel_launch(void* const* d_in, const int* in_sizes, int n_in, void* d_out, int out_size, void* d_ws, size_t ws_size, hipStream_t stream) {
    static int grid = 0;
    if (grid == 0) {
        if (n_in != 15 || in_sizes[0] != M * DM || out_size != M * DM || ws_size < WS_END) {
            fprintf(stderr, "kernel_launch: unexpected shapes (n_in %d, in0 %d, out %d, ws %zu < %zu)\n", n_in, n_in > 0 ? in_sizes[0] : -1, out_size, ws_size, (size_t)WS_END); grid = -1; return; }
        int dev = 0, cus = 0, per_cu = 0;
        hipGetDevice(&dev); hipDeviceGetAttribute(&cus, hipDeviceAttributeMultiprocessorCount, dev);
        hipFuncSetAttribute((const void*)fwd_kernel, hipFuncAttributeMaxDynamicSharedMemorySize, LDS_BYTES);
        hipOccupancyMaxActiveBlocksPerMultiprocessor(&per_cu, (const void*)fwd_kernel, NTHREADS, LDS_BYTES);
        if (per_cu < 1) per_cu = 1;
        (void)hipGetLastError();
        grid = cus * per_cu;
        if (grid > 256) grid = 256;
    }
    if (grid < 0) return;
    Args a{};
    a.x = (const float*)d_in[0]; a.pos = (const int*)d_in[1]; a.w_in = (const float*)d_in[2]; a.w_out = (const float*)d_in[3]; a.w_up = (const float*)d_in[4];
    a.w_down = (const float*)d_in[5]; a.conv_w = (const float*)d_in[6]; a.conv_b = (const float*)d_in[7]; a.sinks = (const float*)d_in[8];
    a.pre_mix = (const float*)d_in[9]; a.post_mix = (const float*)d_in[10]; a.attn_norm = (const float*)d_in[11]; a.ret_norm = (const float*)d_in[12];
    a.pre_ffn = (const float*)d_in[13]; a.post_ffn = (const float*)d_in[14];
    a.out = (float*)d_out; a.ws = (unsigned char*)d_ws;
#if MK_SINGLE
    hipMemsetAsync(d_ws, 0, 16384, stream);
    a.ph_lo = 0; a.ph_hi = NPHASES;
    void* kargs[] = {&a};
    hipError_t e = hipLaunchCooperativeKernel((const void*)fwd_kernel, dim3(grid), dim3(NTHREADS), kargs, LDS_BYTES, stream);
    if (e != hipSuccess) fprintf(stderr, "cooperative launch failed: %s (grid %d)\n", hipGetErrorString(e), grid);
#else
    for (int ph = 0; ph < NPHASES; ++ph) { a.ph_lo = ph; a.ph_hi = ph + 1; hipLaunchKernelGGL(fwd_kernel, dim3(grid), dim3(NTHREADS), LDS_BYTES, stream, a); }
#endif
}
```

```cpp
#include <hip/hip_runtime.h>
#include <hip/hip_cooperative_groups.h>
#include <cstdio>
namespace cg = cooperative_groups;

#ifndef MK_SINGLE
#define MK_SINGLE 1
#endif

#ifndef DBG_MASK
#define DBG_MASK 1023
#endif
#define LAS __attribute__((address_space(3)))
#define GAS __attribute__((address_space(1)))
typedef unsigned short bf16_t;
typedef short bf16x8 __attribute__((ext_vector_type(8)));
typedef short s16x4 __attribute__((ext_vector_type(4)));
typedef float f32x4 __attribute__((ext_vector_type(4)));
typedef float f32x16 __attribute__((ext_vector_type(16)));
typedef unsigned u32x4 __attribute__((ext_vector_type(4)));
typedef unsigned u32x2 __attribute__((ext_vector_type(2)));

constexpr int BATCH = 4, SEQ = 4096, DM = 2048, M = BATCH * SEQ, DIN = 5632, DFF = 5632, NUP = 11264, DEPTH = 2;
constexpr int C_QA = 0, C_KA = 1024, C_VA = 1280, C_QR = 1536, C_KR = 2560, C_VR = 3584, C_GR = 4608;
constexpr float EPS = 1e-6f;
constexpr int NTHREADS = 512, NWAVES = 8;
constexpr int LDS_BYTES = 147456;

constexpr size_t MiB = 1u << 20;
constexpr size_t SZ_WIN = (size_t)DIN * DM * 2, SZ_WOUT = (size_t)DM * DM * 2, SZ_WUP = (size_t)NUP * DM * 2, SZ_WDN = (size_t)DM * DFF * 2;
constexpr size_t WS_WIN = 1 * MiB;
constexpr size_t WS_WOUT = WS_WIN + 2 * SZ_WIN;
constexpr size_t WS_WUP = WS_WOUT + 2 * SZ_WOUT;
constexpr size_t WS_WDN = WS_WUP + 2 * SZ_WUP;
constexpr size_t WS_XN = WS_WDN + 2 * SZ_WDN;
constexpr size_t WS_BIG = WS_XN + (size_t)M * DM * 2;
constexpr size_t WS_MIXIN = WS_BIG + (size_t)M * DIN * 2;
constexpr size_t WS_YARAW = WS_MIXIN + (size_t)M * DM * 2;
constexpr size_t WS_STATE = WS_YARAW + (size_t)M * 1024 * 2;
constexpr size_t WS_ROPEA = WS_STATE + (size_t)BATCH * 4 * 32 * 65536 * 2;
constexpr size_t WS_ROPER = WS_ROPEA + (size_t)M * 16 * 4;
constexpr size_t WS_EDGE = WS_ROPER + (size_t)M * 256 * 4;
constexpr size_t WS_XR = WS_EDGE + (size_t)128 * 4 * NUP * 4;
constexpr size_t WS_END = WS_XR + (size_t)M * DM * 2;
static_assert((size_t)M * DM * 4 <= (size_t)M * DM * 2 + (size_t)M * 1024 * 2 + (size_t)BATCH * 4 * 32 * 65536 * 2, "MIX2 overlay");

__device__ __forceinline__ unsigned pk_bf16(float lo, float hi) {
    typedef float f32x2_t __attribute__((ext_vector_type(2)));
    typedef __bf16 bf16x2_t __attribute__((ext_vector_type(2)));
    f32x2_t v = {lo, hi}; bf16x2_t b = __builtin_convertvector(v, bf16x2_t);
    return __builtin_bit_cast(unsigned, b);
}
__device__ __forceinline__ float bf_lo(unsigned u) { return __uint_as_float(u << 16); }
__device__ __forceinline__ float bf_hi(unsigned u) { return __uint_as_float(u & 0xffff0000u); }
__device__ __forceinline__ float wave_sum(float v) {
#pragma unroll
    for (int o = 1; o < 64; o <<= 1) v += __shfl_xor(v, o);
    return v;
}
__device__ __forceinline__ int crow(int r, int h) { return (r & 3) + 8 * (r >> 2) + 4 * h; }
__device__ __forceinline__ bf16x8 pack8(const f32x16& x, int s) {
    u32x4 p;
    p[0] = pk_bf16(x[8 * s + 0], x[8 * s + 1]); p[1] = pk_bf16(x[8 * s + 2], x[8 * s + 3]);
    p[2] = pk_bf16(x[8 * s + 4], x[8 * s + 5]); p[3] = pk_bf16(x[8 * s + 6], x[8 * s + 7]);
    return __builtin_bit_cast(bf16x8, p);
}
#define MFMA32(a, b, c) __builtin_amdgcn_mfma_f32_32x32x16_bf16((a), (b), (c), 0, 0, 0)
__device__ __forceinline__ float gelu_tanh(float a) {
    const float u = a * (2.3022082f + 0.10294324f * a * a);
    return a * __builtin_amdgcn_rcpf(1.0f + __builtin_amdgcn_exp2f(-u));
}
__device__ __forceinline__ float silu_f(float x) { return x * __builtin_amdgcn_rcpf(1.0f + __builtin_amdgcn_exp2f(-1.4426950409f * x)); }

struct Args {
    const float* x; const int* pos; const float* w_in; const float* w_out; const float* w_up; const float* w_down;
    const float* conv_w; const float* conv_b; const float* sinks; const float* pre_mix; const float* post_mix;
    const float* attn_norm; const float* ret_norm; const float* pre_ffn; const float* post_ffn;
    float* out; unsigned char* ws; int ph_lo, ph_hi;
};

template <int CTRL> __device__ __forceinline__ float dpp_ror(float v) { return __builtin_bit_cast(float, __builtin_amdgcn_update_dpp(0, __builtin_bit_cast(int, v), CTRL, 0xf, 0xf, false)); }

namespace pg8 {
constexpr int BM = 256, BK = 64, HALF = 128, HTB = HALF * BK * 2, STAGE_BYTES = 8 * HTB, NXCD = 8, WGM = 8;
__device__ __forceinline__ int lds_byte(int r, int c) { const int st = (r >> 4) * 2 + (c >> 5), rr = r & 15, cc = c & 31, ob = rr * 64 + cc * 2; return st * 1024 + (ob ^ (((ob >> 9) & 1) << 5)); }
__device__ __forceinline__ void stage_rc(int b, int& R, int& C) { const int st = b / 1024, sb = b % 1024, swz = sb ^ (((sb >> 9) & 1) << 5); R = (st >> 1) * 16 + swz / 64; C = (st & 1) * 32 + (swz % 64) / 2; }
__device__ __forceinline__ int perm32(int rho) { const int n = rho >> 4, i = rho & 15; return 8 * (i >> 2) + 4 * n + (i & 3); }
struct Unit { int pm, pn; };
struct Gemm { const bf16_t* A; const bf16_t* Bt; int M, N, K; };
struct StaticOrder {
    int nM, nN, nwg, G, c;
    __device__ void init(int M_, int N_, int G_, int c_) { nM = M_ / BM; nN = N_ / BM; nwg = nM * nN; G = G_; c = c_; }
    __device__ bool next(int i, Unit& u) const {
        const long L = (long)i * G + c; if (L >= nwg) return false;
        int wgid = (int)L; { const int q = nwg / NXCD, r = nwg % NXCD, xcd = wgid % NXCD, off = wgid / NXCD; wgid = (xcd < r ? xcd * (q + 1) : r * (q + 1) + (xcd - r) * q) + off; }
        const int nig = WGM * nN, gid = wgid / nig, fm = gid * WGM, gsz = (nM - fm) < WGM ? (nM - fm) : WGM;
        u.pm = fm + ((wgid % nig) % gsz); u.pn = (wgid % nig) / gsz; return true;
    }
};

#ifndef PG8_ALIGN
#define PG8_ALIGN true
#endif
#ifndef PG8_SP2
#define PG8_SP2 true
#endif
template <class Epi, bool ALIGN_EPI = PG8_ALIGN, bool SP2 = PG8_SP2>
__device__ __forceinline__ void gemm_phase(LAS unsigned char* lds, const Gemm g, const StaticOrder& S, const Epi& E, const int tid) {
    const int wid = __builtin_amdgcn_readfirstlane(tid >> 6), lane = tid & 63, wr = wid >> 2, wc = wid & 3, fr = lane & 15, fq = lane >> 4;
    const int K = g.K, nt = K / BK;
    unsigned voffA[2], voffB[2];
#pragma unroll
    for (int i = 0; i < 2; ++i) { int R, C; stage_rc(tid * 16 + i * 8192, R, C); const int Rb = Epi::PERM ? ((R & ~31) + perm32(R & 31)) : R;
        const int Ra = Epi::AROWPERM ? (128 * (R >> 6) + 8 * (R & 15) + ((R >> 4) & 3)) : R;
        voffA[i] = (unsigned)(Ra * K + C) * 2u; voffB[i] = (unsigned)(Rb * K + C) * 2u; }
    const size_t kstep = (size_t)(BK * 2);
    const size_t hstepB = (size_t)HALF * K * 2;
    const size_t hstepA = Epi::AROWPERM ? (size_t)4 * K * 2 : (size_t)HALF * K * 2;
    const size_t tstep = (size_t)BM * K * 2;
    const unsigned ldsw = (unsigned)wid * 1024u;
    const int aoff = lds_byte(wr * 64 + fr, fq * 8), boff = lds_byte(wc * 32 + fr, fq * 8);
#define PG8_SA(b, h) (((b) * 2 + (h)) * HTB)
#define PG8_SB(b, h) ((4 + (b) * 2 + (h)) * HTB)
#define PG8_STAGE(bufoff, gbase, voff) do { _Pragma("unroll") for (int _i = 0; _i < 2; ++_i) \
        __builtin_amdgcn_global_load_lds((const unsigned*)((const char*)(gbase) + (voff)[_i]), (LAS unsigned*)(lds + (bufoff) + ldsw + _i * 8192), 16, 0, 0); } while (0)
#define PG8_LDA(dst, b, h) do { _Pragma("unroll") for (int m = 0; m < 4; ++m) _Pragma("unroll") for (int k = 0; k < 2; ++k) dst[m][k] = *(const LAS bf16x8*)(lds + PG8_SA(b, h) + aoff + m * 2048 + k * 1024); } while (0)
#define PG8_LDB(dst, b, h) do { _Pragma("unroll") for (int n = 0; n < 2; ++n) _Pragma("unroll") for (int k = 0; k < 2; ++k) dst[n][k] = *(const LAS bf16x8*)(lds + PG8_SB(b, h) + boff + n * 2048 + k * 1024); } while (0)
#define PG8_MMA(ai, bj, At, Bt) do { __builtin_amdgcn_s_setprio(1); _Pragma("unroll") for (int m = 0; m < 4; ++m) _Pragma("unroll") for (int n = 0; n < 2; ++n) _Pragma("unroll") for (int k = 0; k < 2; ++k) \
        acc[ai][bj][m][n] = __builtin_amdgcn_mfma_f32_16x16x32_bf16(Bt[n][k], At[m][k], acc[ai][bj][m][n], 0, 0, 0); __builtin_amdgcn_s_setprio(0); } while (0)
#define PG8_WAIT_V(n) asm volatile("s_waitcnt vmcnt(" #n ")" ::: "memory")
#define PG8_WAIT_L(n) asm volatile("s_waitcnt lgkmcnt(" #n ")" ::: "memory")
#define PG8_BAR __builtin_amdgcn_s_barrier()
#define PG8_SCHED __builtin_amdgcn_sched_barrier(0)
    Unit cur, nxt; int ui = 0;
    if (!S.next(0, cur)) return;
    f32x4 acc[2][2][4][2];
#pragma unroll
    for (int a = 0; a < 2; ++a)
#pragma unroll
        for (int b = 0; b < 2; ++b)
#pragma unroll
            for (int m = 0; m < 4; ++m)
#pragma unroll
                for (int n = 0; n < 2; ++n) acc[a][b][m][n] = (f32x4){0.f, 0.f, 0.f, 0.f};
    bf16x8 At[4][2], B0[2][2], B1[2][2];
    const char* cA = (const char*)g.A + (size_t)cur.pm * tstep; const char* cB = (const char*)g.Bt + (size_t)cur.pn * tstep;
    f32x4 pre = E.prefetch(cur, wc, lane);
    if constexpr (SP2) {
        PG8_STAGE(PG8_SB(0, 0), cB, voffB); PG8_STAGE(PG8_SB(0, 1), cB + hstepB, voffB); PG8_STAGE(PG8_SA(0, 0), cA, voffA); PG8_STAGE(PG8_SA(0, 1), cA + hstepA, voffA);
        if (wr == 1) PG8_BAR;
        PG8_WAIT_V(2); PG8_BAR;
        PG8_STAGE(PG8_SB(1, 0), cB + kstep, voffB); PG8_STAGE(PG8_SA(1, 0), cA + kstep, voffA); PG8_STAGE(PG8_SB(1, 1), cB + hstepB + kstep, voffB);
        PG8_WAIT_V(6); PG8_BAR;
    } else {
    PG8_STAGE(PG8_SB(0, 0), cB, voffB); PG8_STAGE(PG8_SA(0, 0), cA, voffA); PG8_STAGE(PG8_SB(0, 1), cB + hstepB, voffB); PG8_STAGE(PG8_SA(0, 1), cA + hstepA, voffA);
    if (wr == 1) PG8_BAR;
    PG8_WAIT_V(4); PG8_BAR;
    PG8_STAGE(PG8_SB(1, 0), cB + kstep, voffB); PG8_STAGE(PG8_SA(1, 0), cA + kstep, voffA); PG8_STAGE(PG8_SB(1, 1), cB + hstepB + kstep, voffB);
    PG8_WAIT_V(6); PG8_BAR;
    }
    for (;;) {
        const bool has_next = S.next(ui + 1, nxt);
        const char* nA = has_next ? (const char*)g.A + (size_t)nxt.pm * tstep : cA; const char* nB = has_next ? (const char*)g.Bt + (size_t)nxt.pn * tstep : cB;
        for (int t = 0; t < nt; t += 2) {
            const bool last = (t == nt - 2);
            const char* a1 = cA + (size_t)(t + 1) * kstep;
            const char* a2 = last ? nA : cA + (size_t)(t + 2) * kstep; const char* b2 = last ? nB : cB + (size_t)(t + 2) * kstep;
            const char* a3 = a2 + kstep; const char* b3 = b2 + kstep;
            if constexpr (SP2) {
            PG8_LDB(B0, 0, 0); PG8_LDB(B1, 0, 1); PG8_SCHED; PG8_LDA(At, 0, 0); PG8_STAGE(PG8_SA(1, 1), a1 + hstepA, voffA);
            PG8_WAIT_V(8); PG8_WAIT_L(0); PG8_BAR; PG8_MMA(0, 0, At, B0); PG8_MMA(0, 1, At, B1); PG8_BAR; PG8_SCHED;
            PG8_LDA(At, 0, 1); PG8_STAGE(PG8_SB(0, 0), b2, voffB); PG8_STAGE(PG8_SB(0, 1), b2 + hstepB, voffB); PG8_STAGE(PG8_SA(0, 0), a2, voffA);
            PG8_WAIT_V(8); PG8_WAIT_L(0); PG8_BAR; PG8_MMA(1, 0, At, B0); PG8_MMA(1, 1, At, B1); PG8_BAR; PG8_SCHED;
            PG8_LDB(B0, 1, 0); PG8_LDB(B1, 1, 1); PG8_SCHED; PG8_LDA(At, 1, 0); PG8_STAGE(PG8_SA(0, 1), a2 + hstepA, voffA);
            PG8_WAIT_V(8); PG8_WAIT_L(0); PG8_BAR; PG8_MMA(0, 0, At, B0); PG8_MMA(0, 1, At, B1); PG8_BAR; PG8_SCHED;
            PG8_LDA(At, 1, 1); PG8_STAGE(PG8_SB(1, 0), b3, voffB); PG8_STAGE(PG8_SB(1, 1), b3 + hstepB, voffB); PG8_STAGE(PG8_SA(1, 0), a3, voffA);
            PG8_WAIT_V(8); PG8_WAIT_L(0); PG8_BAR; PG8_MMA(1, 0, At, B0); PG8_MMA(1, 1, At, B1); PG8_BAR; PG8_SCHED;
            } else {
            PG8_LDB(B0, 0, 0); PG8_SCHED; PG8_LDA(At, 0, 0); PG8_STAGE(PG8_SA(1, 1), a1 + hstepA, voffA);
            PG8_WAIT_L(8); PG8_BAR; PG8_WAIT_L(0); PG8_MMA(0, 0, At, B0); PG8_BAR; PG8_SCHED;
            PG8_LDB(B1, 0, 1); PG8_STAGE(PG8_SB(0, 0), b2, voffB);
            PG8_BAR; PG8_WAIT_L(0); PG8_MMA(0, 1, At, B1); PG8_BAR;
            PG8_LDA(At, 0, 1); PG8_STAGE(PG8_SA(0, 0), a2, voffA);
            PG8_BAR; PG8_WAIT_L(0); PG8_MMA(1, 0, At, B0); PG8_BAR; PG8_SCHED;
            PG8_STAGE(PG8_SB(0, 1), b2 + hstepB, voffB);
            PG8_WAIT_V(6); PG8_BAR; PG8_MMA(1, 1, At, B1); PG8_BAR;
            PG8_LDB(B0, 1, 0); PG8_SCHED; PG8_LDA(At, 1, 0); PG8_STAGE(PG8_SA(0, 1), a2 + hstepA, voffA);
            PG8_WAIT_L(8); PG8_BAR; PG8_WAIT_L(0); PG8_MMA(0, 0, At, B0); PG8_BAR; PG8_SCHED;
            PG8_LDB(B1, 1, 1); PG8_STAGE(PG8_SB(1, 0), b3, voffB);
            PG8_BAR; PG8_WAIT_L(0); PG8_MMA(0, 1, At, B1); PG8_BAR;
            PG8_LDA(At, 1, 1); PG8_STAGE(PG8_SA(1, 0), a3, voffA);
            PG8_BAR; PG8_WAIT_L(0); PG8_MMA(1, 0, At, B0); PG8_BAR; PG8_SCHED;
            PG8_STAGE(PG8_SB(1, 1), b3 + hstepB, voffB);
            PG8_WAIT_V(6); PG8_BAR; PG8_MMA(1, 1, At, B1); PG8_BAR;
            }
        }
        if constexpr (ALIGN_EPI) { if (wr == 0) PG8_BAR; }
        E(acc, cur, wr, wc, fr, fq, pre, lds);
        if (!has_next) break;
        pre = E.prefetch(nxt, wc, lane);
#pragma unroll
        for (int a = 0; a < 2; ++a)
#pragma unroll
            for (int b = 0; b < 2; ++b)
#pragma unroll
                for (int m = 0; m < 4; ++m)
#pragma unroll
                    for (int n = 0; n < 2; ++n) acc[a][b][m][n] = (f32x4){0.f, 0.f, 0.f, 0.f};
        cur = nxt; cA = nA; cB = nB; ++ui;
        if constexpr (ALIGN_EPI) { if (wr == 1) PG8_BAR; }
    }
    PG8_WAIT_V(0);
    if constexpr (!ALIGN_EPI) { if (wr == 0) PG8_BAR; }
    PG8_BAR;
#undef PG8_SA
#undef PG8_SB
#undef PG8_STAGE
#undef PG8_LDA
#undef PG8_LDB
#undef PG8_MMA
#undef PG8_WAIT_V
#undef PG8_WAIT_L
#undef PG8_BAR
#undef PG8_SCHED
}

struct EpiF32 {
    static constexpr bool PERM = false, AROWPERM = false;
    float* C; int ldc;
    __device__ __forceinline__ f32x4 prefetch(const Unit&, int, int) const { return (f32x4){0.f, 0.f, 0.f, 0.f}; }
    __device__ __forceinline__ void operator()(const f32x4 (&acc)[2][2][4][2], const Unit& u, int wr, int wc, int fr, int fq, const f32x4&, LAS unsigned char*) const {
        const int row0 = u.pm * BM + wr * 64 + fr, col0 = u.pn * BM + wc * 32 + 4 * fq;
#pragma unroll
        for (int ai = 0; ai < 2; ++ai)
#pragma unroll
            for (int m = 0; m < 4; ++m) { float* rowp = C + (size_t)(row0 + ai * HALF + m * 16) * ldc + col0;
#pragma unroll
                for (int bj = 0; bj < 2; ++bj)
#pragma unroll
                    for (int n = 0; n < 2; ++n) *(f32x4*)(rowp + bj * HALF + n * 16) = acc[ai][bj][m][n]; }
    }
};

struct EpiBf16 {
    static constexpr bool PERM = true, AROWPERM = false;
    bf16_t* O; int ldc;
    __device__ __forceinline__ f32x4 prefetch(const Unit&, int, int) const { return (f32x4){0.f, 0.f, 0.f, 0.f}; }
    __device__ __forceinline__ void operator()(const f32x4 (&acc)[2][2][4][2], const Unit& u, int wr, int wc, int fr, int fq, const f32x4&, LAS unsigned char*) const {
        const int row0 = u.pm * BM + wr * 64 + fr, col0 = u.pn * BM + wc * 32 + 8 * fq;
#pragma unroll
        for (int ai = 0; ai < 2; ++ai)
#pragma unroll
            for (int m = 0; m < 4; ++m) { bf16_t* rowp = O + (size_t)(row0 + ai * HALF + m * 16) * ldc + col0;
#pragma unroll
                for (int bj = 0; bj < 2; ++bj) { const f32x4 v0 = acc[ai][bj][m][0], v1 = acc[ai][bj][m][1];
                    u32x4 w; w.x = pk_bf16(v0[0], v0[1]); w.y = pk_bf16(v0[2], v0[3]); w.z = pk_bf16(v1[0], v1[1]); w.w = pk_bf16(v1[2], v1[3]);
                    *(u32x4*)(rowp + bj * HALF) = w; } }
    }
};

struct EpiProj {
    static constexpr bool PERM = true, AROWPERM = false;
    bf16_t* O; const float* ropeA; const float* ropeR;
    __device__ __forceinline__ f32x4 prefetch(const Unit&, int, int) const { return (f32x4){0.f, 0.f, 0.f, 0.f}; }
    __device__ __forceinline__ void operator()(f32x4 (&acc)[2][2][4][2], const Unit& u, int wr, int wc, int fr, int fq, const f32x4&, LAS unsigned char*) const {
        const int pn = u.pn;
        const int rbase = u.pm * BM + wr * 64 + fr;
        const int cbase = pn * BM + wc * 32 + 8 * fq;
        if (pn <= 4) {
            const float sc = pn < 4 ? 0.125f : 1.0f;
            const bool ropew = (wc & 1) == 0;
#pragma unroll
            for (int ai = 0; ai < 2; ++ai)
#pragma unroll
                for (int m = 0; m < 4; ++m) {
                    const int row = rbase + ai * HALF + m * 16;
                    if (ropew) {
                        const f32x4* tp = (const f32x4*)(ropeA + (size_t)row * 16);
                        const f32x4 cs[2] = {tp[0], tp[1]}; const f32x4 sn[2] = {tp[2], tp[3]};
#pragma unroll
                        for (int bj = 0; bj < 2; ++bj)
#pragma unroll
                            for (int n = 0; n < 2; ++n)
#pragma unroll
                                for (int j = 0; j < 4; ++j) {
                                    const float own = acc[ai][bj][m][n][j]; const float par = __shfl_xor(own, 16);
                                    const float c = cs[n][j], s = sn[n][j];
                                    const float r0 = own * c - par * s, r1 = own * c + par * s;
                                    acc[ai][bj][m][n][j] = (fq == 0) ? r0 : ((fq == 1) ? r1 : own);
                                }
                    }
#pragma unroll
                    for (int bj = 0; bj < 2; ++bj) {
                        const f32x4 v0 = acc[ai][bj][m][0] * sc, v1 = acc[ai][bj][m][1] * sc;
                        u32x4 w; w.x = pk_bf16(v0[0], v0[1]); w.y = pk_bf16(v0[2], v0[3]); w.z = pk_bf16(v1[0], v1[1]); w.w = pk_bf16(v1[2], v1[3]);
                        *(u32x4*)(O + (size_t)row * DIN + cbase + bj * HALF) = w;
                    }
                }
        } else if (pn >= 6 && pn <= 13) {
            const int h = (pn - 6) & 3; const bool isK = pn >= 10;
            const float lg2 = __log2f(1.0f - exp2f(-5.0f - (float)h));
            const int i0 = wc * 32 + 8 * fq;
#pragma unroll
            for (int ai = 0; ai < 2; ++ai)
#pragma unroll
                for (int m = 0; m < 4; ++m) {
                    const int row = rbase + ai * HALF + m * 16;
                    const float p = (float)((row & 127) + 1);
                    const float dec = isK ? 0.0625f * exp2f(-p * lg2) : exp2f(p * lg2);
                    const f32x4* tc = (const f32x4*)(ropeR + (size_t)row * 256 + i0);
                    const f32x4* ts = (const f32x4*)(ropeR + (size_t)row * 256 + 128 + i0);
                    const f32x4 cs[2] = {tc[0], tc[1]}; const f32x4 sn[2] = {ts[0], ts[1]};
#pragma unroll
                    for (int n = 0; n < 2; ++n) {
                        const f32x4 x1 = acc[ai][0][m][n], x2 = acc[ai][1][m][n];
                        acc[ai][0][m][n] = (x1 * cs[n] - x2 * sn[n]) * dec;
                        acc[ai][1][m][n] = (x2 * cs[n] + x1 * sn[n]) * dec;
                    }
#pragma unroll
                    for (int bj = 0; bj < 2; ++bj) {
                        const f32x4 v0 = acc[ai][bj][m][0], v1 = acc[ai][bj][m][1];
                        u32x4 w; w.x = pk_bf16(v0[0], v0[1]); w.y = pk_bf16(v0[2], v0[3]); w.z = pk_bf16(v1[0], v1[1]); w.w = pk_bf16(v1[2], v1[3]);
                        *(u32x4*)(O + (size_t)row * DIN + cbase + bj * HALF) = w;
                    }
                }
        } else {
            const bool gate = pn >= 18;
#pragma unroll
            for (int ai = 0; ai < 2; ++ai)
#pragma unroll
                for (int m = 0; m < 4; ++m) {
                    const int row = rbase + ai * HALF + m * 16;
#pragma unroll
                    for (int bj = 0; bj < 2; ++bj) {
                        f32x4 v0 = acc[ai][bj][m][0], v1 = acc[ai][bj][m][1];
                        if (gate) {
#pragma unroll
                            for (int j = 0; j < 4; ++j) { v0[j] = silu_f(v0[j]); v1[j] = silu_f(v1[j]); }
                        }
                        u32x4 w; w.x = pk_bf16(v0[0], v0[1]); w.y = pk_bf16(v0[2], v0[3]); w.z = pk_bf16(v1[0], v1[1]); w.w = pk_bf16(v1[2], v1[3]);
                        *(u32x4*)(O + (size_t)row * DIN + cbase + bj * HALF) = w;
                    }
                }
        }
    }
};

struct EpiUpConv {
    static constexpr bool PERM = true, AROWPERM = true;
    bf16_t* ACT; float* EDGE; const float* cw; const float* cb;
    __device__ __forceinline__ f32x4 prefetch(const Unit& u, int wc, int lane) const {
        const int k = lane >> 4, part = (lane >> 3) & 1, c = 4 * (lane & 7);
        const float* p = (k < 3 ? cw + (size_t)k * NUP : cb) + part * DFF + u.pn * 128 + wc * 32 + c;
        return *(const f32x4*)p;
    }
    __device__ __forceinline__ void operator()(const f32x4 (&acc)[2][2][4][2], const Unit& u, int wr, int wc, int fr, int fq, const f32x4& pre, LAS unsigned char* lds) const {
        const int lane = fq * 16 + fr;
        LAS float* wl = (LAS float*)(lds + STAGE_BYTES + (wr * 4 + wc) * 1024);
        *(LAS f32x4*)(wl + 4 * lane) = pre;
        const int rowh = u.pm * BM + wr * HALF;
        const int hidx = rowh >> 7;
#pragma unroll
        for (int n = 0; n < 2; ++n) {
            const int ca = u.pn * 128 + wc * 32 + 8 * fq + 4 * n;
            const LAS float* wq = wl + 8 * fq + 4 * n;
            const f32x4 wa0 = *(const LAS f32x4*)(wq), wa1 = *(const LAS f32x4*)(wq + 64), wa2 = *(const LAS f32x4*)(wq + 128), ba = *(const LAS f32x4*)(wq + 192);
            const f32x4 wg0 = *(const LAS f32x4*)(wq + 32), wg1 = *(const LAS f32x4*)(wq + 96), wg2 = *(const LAS f32x4*)(wq + 160), bg = *(const LAS f32x4*)(wq + 224);
            const f32x4 a6 = acc[1][0][2][n], a7 = acc[1][0][3][n], g6 = acc[1][1][2][n], g7 = acc[1][1][3][n];
            f32x4 pa6, pa7, pg6, pg7;
#pragma unroll
            for (int j = 0; j < 4; ++j) { pa6[j] = dpp_ror<0x121>(a6[j]); pa7[j] = dpp_ror<0x121>(a7[j]); pg6[j] = dpp_ror<0x121>(g6[j]); pg7[j] = dpp_ror<0x121>(g7[j]); }
#pragma unroll
            for (int gi = 0; gi < 8; ++gi) {
                const f32x4 a = acc[gi >> 2][0][gi & 3][n], g = acc[gi >> 2][1][gi & 3][n];
                const f32x4 am1 = gi >= 1 ? acc[(gi - 1 + 8) % 8 >> 2][0][(gi - 1 + 8) % 8 & 3][n] : pa7;
                const f32x4 gm1 = gi >= 1 ? acc[(gi - 1 + 8) % 8 >> 2][1][(gi - 1 + 8) % 8 & 3][n] : pg7;
                const f32x4 am2 = gi >= 2 ? acc[(gi - 2 + 8) % 8 >> 2][0][(gi - 2 + 8) % 8 & 3][n] : (gi == 1 ? pa7 : pa6);
                const f32x4 gm2 = gi >= 2 ? acc[(gi - 2 + 8) % 8 >> 2][1][(gi - 2 + 8) % 8 & 3][n] : (gi == 1 ? pg7 : pg6);
                const f32x4 ua = wa0 * am2 + wa1 * am1 + wa2 * a + ba;
                const f32x4 ug = wg0 * gm2 + wg1 * gm1 + wg2 * g + bg;
                const int row = rowh + 8 * fr + gi;
                if (!(gi < 2 && fr == 0)) {
                    u32x2 w; w.x = pk_bf16(gelu_tanh(ua[0]) * ug[0], gelu_tanh(ua[1]) * ug[1]); w.y = pk_bf16(gelu_tanh(ua[2]) * ug[2], gelu_tanh(ua[3]) * ug[3]);
                    *(u32x2*)(ACT + (size_t)row * DFF + ca) = w;
                }
                if (gi < 2 && fr == 0) { float* e = EDGE + (size_t)(hidx * 4 + gi) * NUP; *(f32x4*)(e + ca) = a; *(f32x4*)(e + DFF + ca) = g; }
                if (gi >= 6 && fr == 15) { float* e = EDGE + (size_t)(hidx * 4 + gi - 4) * NUP; *(f32x4*)(e + ca) = a; *(f32x4*)(e + DFF + ca) = g; }
            }
        }
    }
};
}

typedef const Args __attribute__((address_space(4)))* KArgs;
struct Frame {
    LAS unsigned char* lds;
    int tid, lane, wave, G, bid;
    KArgs ka;
    GAS unsigned char* ws;
};
#define WSP(T, off) ((T*)(F.ws + (off)))
#define P_WinT  WSP(bf16_t, WS_WIN)
#define P_WoutT WSP(bf16_t, WS_WOUT)
#define P_WupT  WSP(bf16_t, WS_WUP)
#define P_WdnT  WSP(bf16_t, WS_WDN)
#define P_XN    WSP(bf16_t, WS_XN)
#define P_PROJ  WSP(bf16_t, WS_BIG)
#define P_ACT   WSP(bf16_t, WS_BIG)
#define P_MIX   WSP(float, WS_BIG)
#define P_MIXB  WSP(bf16_t, WS_BIG)
#define P_MIX2B WSP(bf16_t, WS_MIXIN)
#define P_MIXIN WSP(bf16_t, WS_MIXIN)
#define P_MIX2  WSP(float, WS_MIXIN)
#define P_YARAW WSP(bf16_t, WS_YARAW)
#define P_STATE WSP(bf16_t, WS_STATE)
#define P_ROPEA WSP(float, WS_ROPEA)
#define P_ROPER WSP(float, WS_ROPER)
#define P_EDGE  WSP(float, WS_EDGE)
#define P_XR    WSP(bf16_t, WS_XR)

__device__ __forceinline__ void transpose_item(const float* W, int K, int N, bf16_t* WT, int k0, int n0, int drow0, LAS float* scr, int lane) {
#pragma unroll 8
    for (int i = 0; i < 64; ++i) scr[i * 65 + lane] = W[(size_t)(k0 + i) * N + n0 + lane];
    asm volatile("s_waitcnt lgkmcnt(0)" ::: "memory");
    const int c = lane & 7;
#pragma unroll
    for (int j = 0; j < 8; ++j) { const int n = (lane >> 3) + 8 * j; const LAS float* s = scr + (8 * c) * 65 + n;
        u32x4 o; o.x = pk_bf16(s[0 * 65], s[1 * 65]); o.y = pk_bf16(s[2 * 65], s[3 * 65]); o.z = pk_bf16(s[4 * 65], s[5 * 65]); o.w = pk_bf16(s[6 * 65], s[7 * 65]);
        *(u32x4*)(WT + (size_t)(drow0 + n) * K + k0 + 8 * c) = o; }
    asm volatile("s_waitcnt lgkmcnt(0)" ::: "memory");
}
__device__ __forceinline__ void p0_prologue(Frame& F) {
    LAS float* scr = (LAS float*)(F.lds + F.wave * 16640);
    const int gw = F.bid * NWAVES + F.wave, NGW = F.G * NWAVES;
    constexpr int I_IN = (DM / 64) * (DIN / 64), I_OUT = (DM / 64) * (DM / 64), I_UP = (DM / 64) * (NUP / 64), I_DN = (DFF / 64) * (DM / 64);
    constexpr int PER_L = I_IN + I_OUT + I_UP + I_DN;
    for (int it = gw; it < DEPTH * PER_L; it += NGW) {
        const int l = it / PER_L; int r = it % PER_L;
        if (r < I_IN) { const int nb = DIN / 64, kb = r / nb, n0 = 64 * (r % nb); transpose_item(((const float*)(GAS const float*)F.ka->w_in) + (size_t)l * DM * DIN, DM, DIN, P_WinT + (size_t)l * DIN * DM, 64 * kb, n0, n0, scr, F.lane); continue; } r -= I_IN;
        if (r < I_OUT) { const int nb = DM / 64, kb = r / nb, n0 = 64 * (r % nb); transpose_item(((const float*)(GAS const float*)F.ka->w_out) + (size_t)l * DM * DM, DM, DM, P_WoutT + (size_t)l * DM * DM, 64 * kb, n0, n0, scr, F.lane); continue; } r -= I_OUT;
        if (r < I_UP) { const int nb = NUP / 64, kb = r / nb, n0 = 64 * (r % nb);
            const int bj = n0 >= DFF ? 1 : 0, cc = n0 - bj * DFF, drow = 256 * (cc >> 7) + 128 * bj + (cc & 127);
            transpose_item(((const float*)(GAS const float*)F.ka->w_up) + (size_t)l * DM * NUP, DM, NUP, P_WupT + (size_t)l * NUP * DM, 64 * kb, n0, drow, scr, F.lane); continue; } r -= I_UP;
        { const int nb = DM / 64, kb = r / nb, n0 = 64 * (r % nb); transpose_item(((const float*)(GAS const float*)F.ka->w_down) + (size_t)l * DFF * DM, DFF, DM, P_WdnT + (size_t)l * DM * DFF, 64 * kb, n0, n0, scr, F.lane); }
    }
    const int gt = F.bid * NTHREADS + F.tid, NGT = F.G * NTHREADS;
    for (int i = gt; i < M * 8; i += NGT) { const int m = i >> 3, f = i & 7;
        const float inv = powf(500000.0f, -(float)f / 8.0f);
        const double rev = (double)((const int*)(GAS const int*)F.ka->pos)[m] * (double)inv * 0.15915494309189535; const float fr = (float)(rev - floor(rev));
        P_ROPEA[(size_t)m * 16 + f] = __builtin_amdgcn_cosf(fr); P_ROPEA[(size_t)m * 16 + 8 + f] = __builtin_amdgcn_sinf(fr); }
    for (int i = gt; i < M * 128; i += NGT) { const int m = i >> 7, f = i & 127;
        const float inv = powf(10000.0f, -(float)f / 128.0f);
        const double rev = (double)((const int*)(GAS const int*)F.ka->pos)[m] * (double)inv * 0.15915494309189535; const float fr = (float)(rev - floor(rev));
        P_ROPER[(size_t)m * 256 + f] = __builtin_amdgcn_cosf(fr); P_ROPER[(size_t)m * 256 + 128 + f] = __builtin_amdgcn_sinf(fr); }
    for (int m = gw; m < M; m += NGW) {
        const f32x4* xr = (const f32x4*)(((const float*)(GAS const float*)F.ka->x) + (size_t)m * DM) + F.lane; f32x4 v[8]; float ss = 0.f;
#pragma unroll
        for (int j = 0; j < 8; ++j) { v[j] = xr[64 * j]; ss += (v[j].x * v[j].x + v[j].y * v[j].y) + (v[j].z * v[j].z + v[j].w * v[j].w); }
        const float rs = rsqrtf(wave_sum(ss) * (1.0f / DM) + EPS);
        u32x2* o = (u32x2*)(P_XN + (size_t)m * DM) + F.lane; const f32x4* wn = (const f32x4*)((const float*)(GAS const float*)F.ka->pre_mix) + F.lane;
#pragma unroll
        for (int j = 0; j < 8; ++j) { const f32x4 w = wn[64 * j]; u32x2 p; p.x = pk_bf16(v[j].x * rs * w.x, v[j].y * rs * w.y); p.y = pk_bf16(v[j].z * rs * w.z, v[j].w * rs * w.w); o[64 * j] = p; }
    }
}

template <bool XI_F32, bool XO_F32>
__device__ __forceinline__ void rowpass(Frame& F, const void* xi_, const bf16_t* mix, const float* wpost, const float* wnext, void* xo_, bool do_xn) {
    const int gw = F.bid * NWAVES + F.wave, NGW = F.G * NWAVES;
    u32x4 mv[4]; f32x4 xv[4][2];
    auto ldx = [&](int m, int j, f32x4& a, f32x4& b2) {
        const int c8 = 8 * (F.lane + 64 * j);
        if (XI_F32) { const float* p = (const float*)xi_ + (size_t)m * DM + c8; a = __builtin_nontemporal_load((const f32x4*)p); b2 = __builtin_nontemporal_load((const f32x4*)(p + 4)); }
        else { const u32x4 r = __builtin_nontemporal_load((const u32x4*)((const bf16_t*)xi_ + (size_t)m * DM + c8));
               a = (f32x4){bf_lo(r.x), bf_hi(r.x), bf_lo(r.y), bf_hi(r.y)}; b2 = (f32x4){bf_lo(r.z), bf_hi(r.z), bf_lo(r.w), bf_hi(r.w)}; }
    };
    f32x4 wpv[4][2], wnv[4][2];
#pragma unroll
    for (int j = 0; j < 4; ++j) { const int c8 = 8 * (F.lane + 64 * j); wpv[j][0] = *(const f32x4*)(wpost + c8); wpv[j][1] = *(const f32x4*)(wpost + c8 + 4); wnv[j][0] = *(const f32x4*)(wnext + c8); wnv[j][1] = *(const f32x4*)(wnext + c8 + 4); }
    int m = gw;
    if (m < M) {
#pragma unroll
        for (int j = 0; j < 4; ++j) { mv[j] = __builtin_nontemporal_load((const u32x4*)(mix + (size_t)m * DM + 8 * (F.lane + 64 * j))); ldx(m, j, xv[j][0], xv[j][1]); }
    }
    while (m < M) {
        const int mn = m + NGW;
        u32x4 nmv[4]; f32x4 nxv[4][2];
        if (mn < M) {
#pragma unroll
            for (int j = 0; j < 4; ++j) { nmv[j] = __builtin_nontemporal_load((const u32x4*)(mix + (size_t)mn * DM + 8 * (F.lane + 64 * j))); ldx(mn, j, nxv[j][0], nxv[j][1]); }
        } else {
#pragma unroll
            for (int j = 0; j < 4; ++j) { nmv[j] = mv[j]; nxv[j][0] = xv[j][0]; nxv[j][1] = xv[j][1]; }
        }
        f32x4 v[4][2]; float ss = 0.f;
#pragma unroll
        for (int j = 0; j < 4; ++j) {
            v[j][0] = (f32x4){bf_lo(mv[j].x), bf_hi(mv[j].x), bf_lo(mv[j].y), bf_hi(mv[j].y)}; v[j][1] = (f32x4){bf_lo(mv[j].z), bf_hi(mv[j].z), bf_lo(mv[j].w), bf_hi(mv[j].w)};
#pragma unroll
            for (int q = 0; q < 2; ++q) ss += (v[j][q].x * v[j][q].x + v[j][q].y * v[j][q].y) + (v[j][q].z * v[j][q].z + v[j][q].w * v[j][q].w);
        }
        const float rs = rsqrtf(wave_sum(ss) * (1.0f / DM) + EPS);
        float s2 = 0.f;
#pragma unroll
        for (int j = 0; j < 4; ++j) { const int c8 = 8 * (F.lane + 64 * j);
#pragma unroll
            for (int q = 0; q < 2; ++q) { const f32x4 y = xv[j][q] + v[j][q] * rs * wpv[j][q]; v[j][q] = y;
                s2 += (y.x * y.x + y.y * y.y) + (y.z * y.z + y.w * y.w); }
            if (XO_F32) { float* p = (float*)xo_ + (size_t)m * DM + c8; __builtin_nontemporal_store(v[j][0], (f32x4*)p); __builtin_nontemporal_store(v[j][1], (f32x4*)(p + 4)); }
            else { u32x4 p; p.x = pk_bf16(v[j][0].x, v[j][0].y); p.y = pk_bf16(v[j][0].z, v[j][0].w); p.z = pk_bf16(v[j][1].x, v[j][1].y); p.w = pk_bf16(v[j][1].z, v[j][1].w);
                   *(u32x4*)((bf16_t*)xo_ + (size_t)m * DM + c8) = p; }
        }
        if (do_xn) {
            const float rs2 = rsqrtf(wave_sum(s2) * (1.0f / DM) + EPS);
#pragma unroll
            for (int j = 0; j < 4; ++j) { const int c8 = 8 * (F.lane + 64 * j); const f32x4 w0 = wnv[j][0], w1 = wnv[j][1];
                u32x4 p; p.x = pk_bf16(v[j][0].x * rs2 * w0.x, v[j][0].y * rs2 * w0.y); p.y = pk_bf16(v[j][0].z * rs2 * w0.z, v[j][0].w * rs2 * w0.w);
                p.z = pk_bf16(v[j][1].x * rs2 * w1.x, v[j][1].y * rs2 * w1.y); p.w = pk_bf16(v[j][1].z * rs2 * w1.z, v[j][1].w * rs2 * w1.w);
                *(u32x4*)(P_XN + (size_t)m * DM + c8) = p; }
        }
#pragma unroll
        for (int j = 0; j < 4; ++j) { mv[j] = nmv[j]; xv[j][0] = nxv[j][0]; xv[j][1] = nxv[j][1]; }
        m = mn;
    }
}

typedef short v4i16_t __attribute__((ext_vector_type(4)));
__device__ __forceinline__ s16x4 vtr(const LAS unsigned char* p) { return __builtin_bit_cast(s16x4, __builtin_amdgcn_ds_read_tr16_b64_v4i16((LAS v4i16_t*)p)); }
__device__ __forceinline__ bf16x8 vtr8(const LAS unsigned char* lo, const LAS unsigned char* hi) { const s16x4 a = vtr(lo), b = vtr(hi); return __builtin_shufflevector(a, b, 0, 1, 2, 3, 4, 5, 6, 7); }

constexpr int AT_KPB = 144, AT_VPB = 192;
constexpr int AT_V_OFF = 256 * AT_KPB;
__device__ __forceinline__ void attn_load(Frame& F, int unit, u32x4 (&kv)[4], u32x4 (&vv)[4]) {
    const int b = unit >> 7, nb = (unit >> 2) & 31, kvh = unit & 3;
    const int tokc = b * SEQ + nb * 128;
#pragma unroll
    for (int i = 0; i < 4; ++i) {
        const int p = F.tid + NTHREADS * i, row = p >> 3, ch = p & 7;
        const bool valid = (nb > 0) || (row >= 128);
        kv[i] = (u32x4){0u, 0u, 0u, 0u}; vv[i] = (u32x4){0u, 0u, 0u, 0u};
        if (valid) { const bf16_t* src = P_PROJ + (size_t)(tokc - 128 + row) * DIN + 64 * kvh + 8 * ch; kv[i] = *(const u32x4*)(src + C_KA); vv[i] = *(const u32x4*)(src + C_VA); }
    }
}
__device__ __forceinline__ void attn_qload(Frame& F, int unit, int pp, int lane, bf16x8 (&Q)[4]) {
    const int b = unit >> 7, nb = (unit >> 2) & 31, kvh = unit & 3, pass = F.wave + 8 * pp, g = pass >> 2, c = pass & 3, hq = 4 * kvh + g;
    const bf16_t* qp = P_PROJ + (size_t)(b * SEQ + nb * 128 + 32 * c + (lane & 31)) * DIN + C_QA + 64 * hq + 8 * (lane >> 5);
#pragma unroll
    for (int ks = 0; ks < 4; ++ks) Q[ks] = *(const bf16x8*)(qp + 16 * ks);
}
__device__ __forceinline__ void attn_units(Frame& F, int l, int first, int stride) {
    LAS unsigned char* Ks = F.lds; LAS unsigned char* Vs = F.lds + AT_V_OFF;
    u32x4 kv[4], vv[4]; bf16x8 Qn[4];
    if (first < 512) { attn_load(F, first, kv, vv); attn_qload(F, first, 0, F.lane, Qn); }
#pragma unroll 1
  for (int unit = first; unit < 512; unit += stride) {
    int lane_ = F.lane; asm volatile("" : "+v"(lane_));
    const int lane = lane_, r32 = lane & 31, h2 = lane >> 5, tid = F.wave * 64 + lane;
    const int trq = (lane & 15) >> 2, trc = 16 * ((lane >> 4) & 1) + 4 * (lane & 3);
    const int b = unit >> 7, nb = (unit >> 2) & 31, kvh = unit & 3;
    const int tokc = b * SEQ + nb * 128;
    __syncthreads();
#pragma unroll
    for (int i = 0; i < 4; ++i) {
        const int p = tid + NTHREADS * i, row = p >> 3, ch = p & 7;
        *(LAS u32x4*)(Ks + row * AT_KPB + 16 * ch) = kv[i];
        *(LAS u32x4*)(Vs + row * AT_VPB + 16 * ch) = vv[i];
    }
    __syncthreads();
#pragma unroll 1
    for (int pp = 0; pp < 2; ++pp) {
        const int pass = F.wave + 8 * pp, g = pass >> 2, c = pass & 3, hq = 4 * kvh + g;
        const int qrow = tokc + 32 * c + r32;
        bf16x8 Qf[4];
#pragma unroll
        for (int ks = 0; ks < 4; ++ks) Qf[ks] = Qn[ks];
        if (pp == 0) { attn_qload(F, unit, 1, lane, Qn); if (unit + stride < 512) attn_load(F, unit + stride, kv, vv); }
        else if (unit + stride < 512) attn_qload(F, unit + stride, 0, lane, Qn);
        f32x16 s[5];
#pragma unroll
        for (int t = 0; t < 5; ++t) {
#pragma unroll
            for (int r = 0; r < 16; ++r) s[t][r] = 0.f;
#pragma unroll
            for (int ks = 0; ks < 4; ++ks) { const bf16x8 kf = *(const LAS bf16x8*)(Ks + (32 * (c + t) + r32) * AT_KPB + (16 * ks + 8 * h2) * 2); s[t] = MFMA32(kf, Qf[ks], s[t]); }
            __builtin_amdgcn_sched_barrier(0);
        }
        const float sink = ((const float*)(GAS const float*)F.ka->sinks)[l * 16 + hq];
        float mx = sink;
#pragma unroll
        for (int t = 0; t < 5; ++t) {
            const bool tile_ok = (nb > 0) || (c + t >= 4);
#pragma unroll
            for (int r = 0; r < 16; ++r) {
                float v = s[t][r];
                if (t == 0) v = (crow(r, h2) > r32) ? v : -1e30f;
                if (t == 4) v = (crow(r, h2) <= r32) ? v : -1e30f;
                v = tile_ok ? v : -1e30f;
                s[t][r] = v; mx = fmaxf(mx, v);
            }
        }
        mx = fmaxf(mx, __shfl_xor(mx, 32));
        float sum = 0.f;
#pragma unroll
        for (int t = 0; t < 5; ++t)
#pragma unroll
            for (int r = 0; r < 16; ++r) { const float p = __expf(s[t][r] - mx); s[t][r] = p; sum += p; }
        sum += __shfl_xor(sum, 32);
        __builtin_amdgcn_sched_barrier(0);
        const float inv = 1.0f / (sum + __expf(sink - mx));
        f32x16 o[2];
#pragma unroll
        for (int db = 0; db < 2; ++db)
#pragma unroll
            for (int r = 0; r < 16; ++r) o[db][r] = 0.f;
#pragma unroll
        for (int t = 0; t < 5; ++t) {
#pragma unroll
            for (int r = 0; r < 16; ++r) s[t][r] *= inv;
#pragma unroll
            for (int sk = 0; sk < 2; ++sk) {
                const bf16x8 pb = pack8(s[t], sk);
#pragma unroll
                for (int db = 0; db < 2; ++db) {
                    const LAS unsigned char* vp = Vs + (32 * (c + t) + 16 * sk + 4 * h2 + trq) * AT_VPB + (32 * db + trc) * 2;
                    const bf16x8 va = vtr8(vp, vp + 8 * AT_VPB);
                    o[db] = MFMA32(va, pb, o[db]);
                }
            }
            __builtin_amdgcn_sched_barrier(0);
        }
#pragma unroll
        for (int db = 0; db < 2; ++db)
#pragma unroll
            for (int rq = 0; rq < 4; ++rq) { const int d0 = 32 * db + 8 * rq + 4 * h2;
                u32x2 w; w.x = pk_bf16(o[db][4 * rq], o[db][4 * rq + 1]); w.y = pk_bf16(o[db][4 * rq + 2], o[db][4 * rq + 3]);
                *(u32x2*)(P_YARAW + (size_t)qrow * 1024 + 64 * hq + d0) = w; }
    }
  }
}

constexpr int RS_KPB = 576, RS_VPB = 64;
constexpr int RS_V_OFF = 128 * RS_KPB;
__device__ __forceinline__ void ret_scan_task(Frame& F, int task) {
    const int b = task >> 5, h = (task >> 3) & 3, e = task & 7;
    LAS unsigned char* Kt = F.lds; LAS unsigned char* Vs = F.lds + RS_V_OFF;
    const int lane = F.lane, r32 = lane & 31, h2 = lane >> 5, w = F.wave;
    const int trq = (lane & 15) >> 2, trc = 16 * ((lane >> 4) & 1) + 4 * (lane & 3);
    const float lg2 = __log2f(1.0f - exp2f(-5.0f - (float)h));
    const float g128 = exp2f(128.0f * lg2);
    f32x16 st;
#pragma unroll
    for (int r = 0; r < 16; ++r) st[r] = 0.f;
    u32x4 kA[8], vA, kB[8], vB;
    const bf16_t* kbase = P_PROJ + (size_t)(b * SEQ) * DIN + C_KR + 256 * h;
    const bf16_t* vbase = P_PROJ + (size_t)(b * SEQ) * DIN + C_VR + 256 * h + 32 * e;
#define RS_LOAD(KR, VR, cc) do { const size_t adv_ = (size_t)(128 * (cc)) * DIN; \
        _Pragma("unroll") for (int i = 0; i < 8; ++i) { const int p = tid_ + NTHREADS * i; KR[i] = *(const u32x4*)(kbase + adv_ + (size_t)(p >> 5) * DIN + 8 * (p & 31)); } \
        VR = *(const u32x4*)(vbase + adv_ + (size_t)(tid_ >> 2) * DIN + 8 * (tid_ & 3)); } while (0)
#define RS_STEP(KR, VR, cc) do { \
        __syncthreads(); \
        _Pragma("unroll") for (int i = 0; i < 8; ++i) { const int p = tid_ + NTHREADS * i; *(LAS u32x4*)(Kt + (p >> 5) * RS_KPB + 16 * (p & 31)) = KR[i]; } \
        *(LAS u32x4*)(Vs + (tid_ >> 2) * RS_VPB + 16 * (tid_ & 3)) = VR; \
        { bf16_t* sp = P_STATE + ((size_t)((b * 4 + h) * 32 + (cc))) * 65536 + 32 * w + r32_; \
          _Pragma("unroll") for (int r = 0; r < 16; ++r) sp[(size_t)(32 * e + crow(r, h2_)) * 256] = (bf16_t)(pk_bf16(st[r], 0.f) & 0xffffu); } \
        __syncthreads(); \
        if ((cc) + 2 < 32) RS_LOAD(KR, VR, (cc) + 2); \
        _Pragma("unroll") for (int ks = 0; ks < 8; ++ks) { \
            const LAS unsigned char* ap = Vs + (16 * ks + 8 * h2_ + trq_) * RS_VPB + trc_ * 2; \
            const LAS unsigned char* bp = Kt + (16 * ks + 8 * h2_ + trq_) * RS_KPB + (32 * w + trc_) * 2; \
            const bf16x8 af = vtr8(ap, ap + 4 * RS_VPB); const bf16x8 bfr = vtr8(bp, bp + 4 * RS_KPB); \
            st = MFMA32(af, bfr, st); } \
        _Pragma("unroll") for (int r = 0; r < 16; ++r) st[r] *= g128; } while (0)
    { const int tid_ = F.tid; RS_LOAD(kA, vA, 0); RS_LOAD(kB, vB, 1); }
#pragma unroll 1
    for (int c = 0; c < 32; c += 2) {
        int tid_ = F.tid; asm volatile("" : "+v"(tid_));
        const int l_ = tid_ & 63, r32_ = l_ & 31, h2_ = l_ >> 5, trq_ = (l_ & 15) >> 2, trc_ = 16 * ((l_ >> 4) & 1) + 4 * (l_ & 3);
        RS_STEP(kA, vA, c); RS_STEP(kB, vB, c + 1);
    }
#undef RS_LOAD
#undef RS_STEP
}

constexpr int RO_KPB = 528, RO_VPB = 576;
constexpr int RO_V_OFF = 128 * RO_KPB;
constexpr int RO_RED_OFF = RO_V_OFF + 128 * RO_VPB;
__device__ __forceinline__ void ret_out_task(Frame& F, int l, int task) {
    const int b = task >> 7, h = (task >> 5) & 3, c = task & 31;
    const int tok0 = b * SEQ + 128 * c;
    LAS unsigned char* Kc = F.lds; LAS unsigned char* Vs = F.lds + RO_V_OFF; LAS float* red = (LAS float*)(F.lds + RO_RED_OFF);
    int lane_ = F.lane; asm volatile("" : "+v"(lane_));
    const int lane = lane_, r32 = lane & 31, h2 = lane >> 5, w = F.wave, ib = w & 3, hv = w >> 2;
    const int trq = (lane & 15) >> 2, trc = 16 * ((lane >> 4) & 1) + 4 * (lane & 3);
    __syncthreads();
    {
        const unsigned char* sg = (const unsigned char*)(P_STATE + ((size_t)((b * 4 + h) * 32 + c)) * 65536);
#pragma unroll 1
        for (int i = 0; i < 16; ++i) {
            const int k = w + 8 * i, row = 2 * k + (lane >> 5), ch = (lane & 31) ^ (row & 31);
            __builtin_amdgcn_global_load_lds((const unsigned*)(sg + (size_t)row * 512 + ch * 16), (LAS unsigned*)(F.lds + k * 1024), 16, 0, 0);
        }
    }
    const bf16_t* qrow = P_PROJ + (size_t)(tok0 + 32 * ib + r32) * DIN + C_QR + 256 * h + 8 * h2;
    bf16x8 Qf[16];
#pragma unroll
    for (int ks = 0; ks < 16; ++ks) Qf[ks] = *(const bf16x8*)(qrow + 16 * ks);
    asm volatile("s_waitcnt vmcnt(0)" ::: "memory");
    __syncthreads();
    __builtin_amdgcn_sched_barrier(0);
    u32x4 kreg[8], vreg[8];
#pragma unroll
    for (int i = 0; i < 8; ++i) { const int p = (w * 64 + lane) + NTHREADS * i, row = p >> 5, ch = p & 31;
        const bf16_t* src = P_PROJ + (size_t)(tok0 + row) * DIN + 256 * h + 8 * ch;
        kreg[i] = *(const u32x4*)(src + C_KR); vreg[i] = *(const u32x4*)(src + C_VR); }
    __builtin_amdgcn_sched_barrier(0);
    f32x16 o[4];
#pragma unroll
    for (int t = 0; t < 4; ++t)
#pragma unroll
        for (int r = 0; r < 16; ++r) o[t][r] = 0.f;
#pragma unroll
    for (int ks = 0; ks < 16; ++ks) {
#pragma unroll
        for (int t = 0; t < 4; ++t) { const bf16x8 sa = *(const LAS bf16x8*)(F.lds + (128 * hv + 32 * t + r32) * 512 + (((2 * ks + h2) ^ r32) * 16)); o[t] = MFMA32(sa, Qf[ks], o[t]); }
        __builtin_amdgcn_sched_barrier(0);
    }
    __builtin_amdgcn_sched_barrier(0);
    __syncthreads();
#pragma unroll
    for (int i = 0; i < 8; ++i) { const int p = (w * 64 + lane) + NTHREADS * i, row = p >> 5, ch = p & 31;
        *(LAS u32x4*)(Kc + row * RO_KPB + 16 * ch) = kreg[i];
        *(LAS u32x4*)(Vs + row * RO_VPB + 16 * ch) = vreg[i]; }
    __syncthreads();
    __builtin_amdgcn_sched_barrier(0);
#pragma unroll
    for (int jb = 0; jb < 4; ++jb) if (jb <= ib) {
        f32x16 sA, sB;
#pragma unroll
        for (int r = 0; r < 16; ++r) { sA[r] = 0.f; sB[r] = 0.f; }
#pragma unroll
        for (int ks = 0; ks < 16; ks += 2) {
            const bf16x8 k0 = *(const LAS bf16x8*)(Kc + (32 * jb + r32) * RO_KPB + (16 * ks + 8 * h2) * 2);
            const bf16x8 k1 = *(const LAS bf16x8*)(Kc + (32 * jb + r32) * RO_KPB + (16 * (ks + 1) + 8 * h2) * 2);
            sA = MFMA32(k0, Qf[ks], sA); sB = MFMA32(k1, Qf[ks + 1], sB);
            __builtin_amdgcn_sched_barrier(0);
        }
#pragma unroll
        for (int r = 0; r < 16; ++r) { sA[r] += sB[r]; if (jb == ib && crow(r, h2) > r32) sA[r] = 0.f; }
#pragma unroll
        for (int sk = 0; sk < 2; ++sk) {
            const bf16x8 pb = pack8(sA, sk);
#pragma unroll
            for (int t = 0; t < 4; ++t) {
                const LAS unsigned char* vp = Vs + (32 * jb + 16 * sk + 4 * h2 + trq) * RO_VPB + (128 * hv + 32 * t + trc) * 2;
                const bf16x8 va = vtr8(vp, vp + 8 * RO_VPB);
                o[t] = MFMA32(va, pb, o[t]);
            }
        }
        __builtin_amdgcn_sched_barrier(0);
    }
    float ss = 0.f;
#pragma unroll
    for (int t = 0; t < 4; ++t)
#pragma unroll
        for (int r = 0; r < 16; ++r) ss += o[t][r] * o[t][r];
    ss += __shfl_xor(ss, 32);
    if (lane < 32) red[w * 32 + lane] = ss;
    __syncthreads();
    const float tot = red[w * 32 + r32] + red[(w ^ 4) * 32 + r32];
    const float rs = rsqrtf(tot * (1.0f / 256.0f) + EPS);
    const int tok = tok0 + 32 * ib + r32;
#pragma unroll
    for (int t = 0; t < 4; ++t)
#pragma unroll
        for (int rq = 0; rq < 4; ++rq) {
            const int dv0 = 128 * hv + 32 * t + 8 * rq + 4 * h2;
            const u32x2 gt = *(const u32x2*)(P_PROJ + (size_t)tok * DIN + C_GR + 256 * h + dv0);
            const f32x4 wn = *(const f32x4*)(((const float*)(GAS const float*)F.ka->ret_norm) + (size_t)l * 1024 + 256 * h + dv0);
            const float y0 = o[t][4 * rq] * rs * wn[0] * bf_lo(gt.x), y1 = o[t][4 * rq + 1] * rs * wn[1] * bf_hi(gt.x);
            const float y2 = o[t][4 * rq + 2] * rs * wn[2] * bf_lo(gt.y), y3 = o[t][4 * rq + 3] * rs * wn[3] * bf_hi(gt.y);
            u32x2 wv; wv.x = pk_bf16(y0, y1); wv.y = pk_bf16(y2, y3);
            *(u32x2*)(P_MIXIN + (size_t)tok * DM + 1024 + 256 * h + dv0) = wv;
        }
}

__device__ __forceinline__ void attn_norm_rows(Frame& F, int l) {
    const int gw = F.bid * NWAVES + F.wave, NGW = F.G * NWAVES;
    const f32x4* wn = (const f32x4*)(((const float*)(GAS const float*)F.ka->attn_norm) + (size_t)l * 1024);
    f32x4 wv[2][2];
#pragma unroll
    for (int j = 0; j < 2; ++j) { const int col = 8 * (F.lane + 64 * j); wv[j][0] = wn[col / 4]; wv[j][1] = wn[col / 4 + 1]; }
    for (int m0 = gw; m0 < M; m0 += 4 * NGW) {
        u32x4 v[4][2];
#pragma unroll
        for (int i = 0; i < 4; ++i) { const int m = m0 + i * NGW; if (m < M) { const u32x4* src = (const u32x4*)(P_YARAW + (size_t)m * 1024) + F.lane; v[i][0] = src[0]; v[i][1] = src[64]; } else { v[i][0] = (u32x4){0u, 0u, 0u, 0u}; v[i][1] = v[i][0]; } }
#pragma unroll
        for (int i = 0; i < 4; ++i) {
            const int m = m0 + i * NGW;
            float f[16]; float ss = 0.f;
#pragma unroll
            for (int j = 0; j < 2; ++j)
#pragma unroll
                for (int q = 0; q < 4; ++q) { f[8 * j + 2 * q] = bf_lo(v[i][j][q]); f[8 * j + 2 * q + 1] = bf_hi(v[i][j][q]); }
#pragma unroll
            for (int q = 0; q < 16; ++q) ss += f[q] * f[q];
            const float rs = rsqrtf(wave_sum(ss) * (1.0f / 1024.0f) + EPS);
            if (m < M) {
#pragma unroll
                for (int j = 0; j < 2; ++j) { const int col = 8 * (F.lane + 64 * j); const f32x4 w0 = wv[j][0], w1 = wv[j][1];
                    u32x4 o; o.x = pk_bf16(f[8 * j] * rs * w0[0], f[8 * j + 1] * rs * w0[1]); o.y = pk_bf16(f[8 * j + 2] * rs * w0[2], f[8 * j + 3] * rs * w0[3]);
                    o.z = pk_bf16(f[8 * j + 4] * rs * w1[0], f[8 * j + 5] * rs * w1[1]); o.w = pk_bf16(f[8 * j + 6] * rs * w1[2], f[8 * j + 7] * rs * w1[3]);
                    *(u32x4*)(P_MIXIN + (size_t)m * DM + col) = o; }
            }
        }
    }
}

__device__ __forceinline__ void conv_fixup(Frame& F, int l) {
    const float* cw = ((const float*)(GAS const float*)F.ka->conv_w) + (size_t)l * 3 * NUP; const float* cb = ((const float*)(GAS const float*)F.ka->conv_b) + (size_t)l * NUP;
    const int gt = F.bid * NTHREADS + F.tid, NGT = F.G * NTHREADS;
    constexpr int CG = DFF / 4;
    for (int idx = gt; idx < 128 * 2 * CG; idx += NGT) {
        const int cg4 = idx % CG, r = (idx / CG) & 1, hi = idx / (2 * CG);
        const int ca = 4 * cg4; const bool hasprev = (hi & 31) != 0;
        const f32x4 z = {0.f, 0.f, 0.f, 0.f};
        const float* e0 = P_EDGE + (size_t)(hi * 4) * NUP; const float* ep = P_EDGE + (size_t)((hi - 1) * 4) * NUP;
        f32x4 a0, a1, a2, g0, g1, g2;
        if (r == 0) {
            a2 = *(const f32x4*)(e0 + ca); g2 = *(const f32x4*)(e0 + DFF + ca);
            a1 = hasprev ? *(const f32x4*)(ep + 3 * NUP + ca) : z; g1 = hasprev ? *(const f32x4*)(ep + 3 * NUP + DFF + ca) : z;
            a0 = hasprev ? *(const f32x4*)(ep + 2 * NUP + ca) : z; g0 = hasprev ? *(const f32x4*)(ep + 2 * NUP + DFF + ca) : z;
        } else {
            a2 = *(const f32x4*)(e0 + NUP + ca); g2 = *(const f32x4*)(e0 + NUP + DFF + ca);
            a1 = *(const f32x4*)(e0 + ca); g1 = *(const f32x4*)(e0 + DFF + ca);
            a0 = hasprev ? *(const f32x4*)(ep + 3 * NUP + ca) : z; g0 = hasprev ? *(const f32x4*)(ep + 3 * NUP + DFF + ca) : z;
        }
        const f32x4 ua = *(const f32x4*)(cw + ca) * a0 + *(const f32x4*)(cw + NUP + ca) * a1 + *(const f32x4*)(cw + 2 * NUP + ca) * a2 + *(const f32x4*)(cb + ca);
        const f32x4 ug = *(const f32x4*)(cw + DFF + ca) * g0 + *(const f32x4*)(cw + NUP + DFF + ca) * g1 + *(const f32x4*)(cw + 2 * NUP + DFF + ca) * g2 + *(const f32x4*)(cb + DFF + ca);
        u32x2 w; w.x = pk_bf16(gelu_tanh(ua[0]) * ug[0], gelu_tanh(ua[1]) * ug[1]); w.y = pk_bf16(gelu_tanh(ua[2]) * ug[2], gelu_tanh(ua[3]) * ug[3]);
        *(u32x2*)(P_ACT + (size_t)(128 * hi + r) * DFF + ca) = w;
    }
}


#define XB_TMO      128
#define XB_XCNT(j)  (256  + 64 * (j))
#define XB_XSUB(j)  (1280 + 64 * (j))
#define XB_XGEN(j)  (2304 + 64 * (j))
#define XB_TOP      3328
#define XB_TOPGEN   3392
#define XCD_BAR_WORDS 3456
#define XB_SPIN_CAP (1u << 18)
__device__ __forceinline__ unsigned xb_ld(unsigned* p)              { return __hip_atomic_load(p, __ATOMIC_RELAXED, __HIP_MEMORY_SCOPE_AGENT); }
__device__ __forceinline__ unsigned xb_add(unsigned* p, unsigned v) { return __hip_atomic_fetch_add(p, v, __ATOMIC_RELAXED, __HIP_MEMORY_SCOPE_AGENT); }
__device__ __forceinline__ unsigned xb_xcc_id() { return (unsigned)__builtin_amdgcn_s_getreg((3 << 11) | 20) & 0xFu; }
#define XB_SPIN(cond, bar) do { unsigned _sp = 0; while (cond) { __builtin_amdgcn_s_sleep(1); \
    if ((++_sp & 255u) == 0u) { if (xb_ld(&(bar)[XB_TMO])) break; if (_sp > XB_SPIN_CAP) { atomicAdd(&(bar)[XB_TMO], 1u); break; } } } } while (0)
struct XcdBarrier { unsigned* bar; unsigned x; volatile LAS unsigned* st; };
__device__ __forceinline__ XcdBarrier xcd_barrier_post(unsigned* bar, volatile LAS unsigned* st) {
    XcdBarrier b; b.bar = bar; b.x = xb_xcc_id(); b.st = st;
    if (threadIdx.x == 0) (void)xb_add(&bar[XB_XCNT(b.x)], 1u);
    return b;
}
__device__ __forceinline__ void xcd_barrier_complete(unsigned* bar, unsigned x, unsigned& nloc, unsigned& nx) {
    const unsigned G = gridDim.x * gridDim.y * gridDim.z;
    unsigned sum, cnt, mine, sp = 0u;
    for (;;) {
        sum = 0u; cnt = 0u; mine = 0u;
#pragma unroll
        for (unsigned j = 0; j < 16; ++j) { const unsigned c = xb_ld(&bar[XB_XCNT(j)]); sum += c; cnt += (c > 0u) ? 1u : 0u; mine = (j == x) ? c : mine; }
        if (sum == G) break;
        __builtin_amdgcn_s_sleep(1);
        if ((++sp & 255u) == 0u) { if (xb_ld(&bar[XB_TMO])) break; if (sp > XB_SPIN_CAP) { atomicAdd(&bar[XB_TMO], 1u); break; } }
    }
    nloc = mine > 0u ? mine : 1u; nx = cnt > 0u ? cnt : 1u;
}
__device__ __forceinline__ void xcd_barrier(const XcdBarrier& b) {
    asm volatile("s_waitcnt vmcnt(0)" ::: "memory");
    __syncthreads();
    if (threadIdx.x == 0) {
        unsigned* bar = b.bar;
        __builtin_amdgcn_s_waitcnt(0);
        unsigned nloc = b.st[0], nx = b.st[1];
        if (nloc == 0u) { xcd_barrier_complete(bar, b.x, nloc, nx); b.st[0] = nloc; b.st[1] = nx; }
        const unsigned old = xb_add(&bar[XB_XSUB(b.x)], 1u);
        const unsigned gen = old / nloc;
        if (old + 1u == (gen + 1u) * nloc) {
            __builtin_amdgcn_fence(__ATOMIC_RELEASE, "agent");
            asm volatile("s_waitcnt vmcnt(0)" ::: "memory");
            const unsigned og = xb_add(&bar[XB_TOP], 1u);
            const unsigned tg = og / nx;
            if (og + 1u == (tg + 1u) * nx) xb_add(&bar[XB_TOPGEN], 1u);
            else XB_SPIN(xb_ld(&bar[XB_TOPGEN]) == tg, bar);
            __builtin_amdgcn_fence(__ATOMIC_ACQUIRE, "agent");
            xb_add(&bar[XB_XGEN(b.x)], 1u);
            asm volatile("s_waitcnt vmcnt(0)" ::: "memory");
        } else {
            XB_SPIN(xb_ld(&bar[XB_XGEN(b.x)]) == gen, bar);
            __builtin_amdgcn_fence(__ATOMIC_ACQUIRE, "agent");
            asm volatile("s_waitcnt vmcnt(0)" ::: "memory");
        }
    }
    __syncthreads();
}
constexpr int LDS_BARW_OFF = LDS_BYTES - 64;

constexpr int NPHASES = 1 + DEPTH * 9;
__global__ void __launch_bounds__(NTHREADS, 2) fwd_kernel(Args args) {
    extern __shared__ __attribute__((aligned(16))) unsigned char lds_raw[];
    Frame F;
    F.lds = (LAS unsigned char*)lds_raw;
    F.tid = threadIdx.x; F.lane = F.tid & 63; F.wave = __builtin_amdgcn_readfirstlane(F.tid >> 6);
    F.G = gridDim.x; F.bid = blockIdx.x; F.ka = (KArgs)__builtin_amdgcn_kernarg_segment_ptr();
    F.ws = (GAS unsigned char*)F.ka->ws;

    if (threadIdx.x < 16) ((LAS unsigned*)(F.lds + LDS_BARW_OFF))[threadIdx.x] = 0u;
    __syncthreads();
    const XcdBarrier xbar = xcd_barrier_post((unsigned*)(GAS unsigned*)F.ka->ws, (volatile LAS unsigned*)(F.lds + LDS_BARW_OFF));
    const int ph_hi = F.ka->ph_hi;
    for (int ph = F.ka->ph_lo; ph < ph_hi; ++ph) {
        { int t_ = threadIdx.x; asm volatile("" : "+v"(t_)); F.tid = t_; F.lane = t_ & 63; F.wave = __builtin_amdgcn_readfirstlane(t_ >> 6);
          int b_ = blockIdx.x; asm volatile("" : "+s"(b_)); F.bid = b_; int g_ = gridDim.x; asm volatile("" : "+s"(g_)); F.G = g_;
          unsigned long long w_ = (unsigned long long)F.ka->ws; asm volatile("" : "+s"(w_)); F.ws = (GAS unsigned char*)w_;
          unsigned l_ = (unsigned)(size_t)lds_raw; asm volatile("" : "+s"(l_)); F.lds = (LAS unsigned char*)(size_t)l_; }
        if (ph == 0) {
            if (DBG_MASK & 1) p0_prologue(F);
        } else {
            const int l = (ph - 1) / 9, sp = (ph - 1) % 9;
            if (sp == 0 && (DBG_MASK & 2)) {
                pg8::Gemm g{P_XN, P_WinT + (size_t)l * DIN * DM, M, DIN, DM}; pg8::StaticOrder S; S.init(M, DIN, F.G, F.bid);
                pg8::EpiProj E{P_PROJ, P_ROPEA, P_ROPER};
                pg8::gemm_phase<pg8::EpiProj>(F.lds, g, S, E, F.tid);
            } else if (sp == 1 && (DBG_MASK & 4)) {
                if (F.G >= 256) {
                    if (F.bid < 128) ret_scan_task(F, F.bid);
                    else attn_units(F, l, F.bid - 128, F.G - 128);
                } else {
                    for (int t = F.bid; t < 128 + 512; t += F.G) { if (t < 128) ret_scan_task(F, t); else attn_units(F, l, t - 128, 512); }
                }
            } else if (sp == 2 && (DBG_MASK & 8)) {
                for (int t = F.bid; t < 512; t += F.G) ret_out_task(F, l, t);
                attn_norm_rows(F, l);
            } else if (sp == 3 && (DBG_MASK & 16)) {
                pg8::Gemm g{P_MIXIN, P_WoutT + (size_t)l * DM * DM, M, DM, DM}; pg8::StaticOrder S; S.init(M, DM, F.G, F.bid);
                pg8::EpiBf16 E{P_MIXB, DM};
                pg8::gemm_phase<pg8::EpiBf16>(F.lds, g, S, E, F.tid);
            } else if (sp == 4 && (DBG_MASK & 32)) {
                if (l == 0) rowpass<true, false>(F, ((const float*)(GAS const float*)F.ka->x), P_MIXB, ((const float*)(GAS const float*)F.ka->post_mix), ((const float*)(GAS const float*)F.ka->pre_ffn), P_XR, true);
                else rowpass<false, false>(F, P_XR, P_MIXB, ((const float*)(GAS const float*)F.ka->post_mix) + (size_t)l * DM, ((const float*)(GAS const float*)F.ka->pre_ffn) + (size_t)l * DM, P_XR, true);
            } else if (sp == 5 && (DBG_MASK & 64)) {
                pg8::Gemm g{P_XN, P_WupT + (size_t)l * NUP * DM, M, NUP, DM}; pg8::StaticOrder S; S.init(M, NUP, F.G, F.bid);
                pg8::EpiUpConv E{P_ACT, P_EDGE, ((const float*)(GAS const float*)F.ka->conv_w) + (size_t)l * 3 * NUP, ((const float*)(GAS const float*)F.ka->conv_b) + (size_t)l * NUP};
                pg8::gemm_phase<pg8::EpiUpConv>(F.lds, g, S, E, F.tid);
            } else if (sp == 6 && (DBG_MASK & 128)) {
                conv_fixup(F, l);
            } else if (sp == 7 && (DBG_MASK & 256)) {
                pg8::Gemm g{P_ACT, P_WdnT + (size_t)l * DM * DFF, M, DM, DFF}; pg8::StaticOrder S; S.init(M, DM, F.G, F.bid);
                pg8::EpiBf16 E{P_MIX2B, DM};
                pg8::gemm_phase<pg8::EpiBf16>(F.lds, g, S, E, F.tid);
            } else if (sp == 8 && (DBG_MASK & 512)) {
                if (l + 1 < DEPTH) rowpass<false, false>(F, P_XR, P_MIX2B, ((const float*)(GAS const float*)F.ka->post_ffn) + (size_t)l * DM, ((const float*)(GAS const float*)F.ka->pre_mix) + (size_t)(l + 1) * DM, P_XR, true);
                else rowpass<false, true>(F, P_XR, P_MIX2B, ((const float*)(GAS const float*)F.ka->post_ffn) + (size_t)l * DM, ((const float*)(GAS const float*)F.ka->pre_mix), ((float*)(GAS float*)F.ka->out), false);
            }
        }
        if (ph + 1 < ph_hi) {
            if (ph_hi > NPHASES) { __syncthreads(); cg::this_grid().sync(); }
            else xcd_barrier(xbar);
        }
    }
}

extern "C" void kernel_launch(void* const* d_in, const int* in_sizes, int n_in, void* d_out, int out_size, void* d_ws, size_t ws_size, hipStream_t stream) {
    static int grid = 0;
    if (grid == 0) {
        if (n_in != 15 || in_sizes[0] != M * DM || out_size != M * DM || ws_size < WS_END) {
            fprintf(stderr, "kernel_launch: unexpected shapes (n_in %d, in0 %d, out %d, ws %zu < %zu)\n", n_in, n_in > 0 ? in_sizes[0] : -1, out_size, ws_size, (size_t)WS_END); grid = -1; return; }
        int dev = 0, cus = 0, per_cu = 0;
        hipGetDevice(&dev); hipDeviceGetAttribute(&cus, hipDeviceAttributeMultiprocessorCount, dev);
        hipFuncSetAttribute((const void*)fwd_kernel, hipFuncAttributeMaxDynamicSharedMemorySize, LDS_BYTES);
        hipOccupancyMaxActiveBlocksPerMultiprocessor(&per_cu, (const void*)fwd_kernel, NTHREADS, LDS_BYTES);
        if (per_cu < 1) per_cu = 1;
        (void)hipGetLastError();
        grid = cus * per_cu;
        if (grid > 256) grid = 256;
    }
    if (grid < 0) return;
    Args a{};
    a.x = (const float*)d_in[0]; a.pos = (const int*)d_in[1]; a.w_in = (const float*)d_in[2]; a.w_out = (const float*)d_in[3]; a.w_up = (const float*)d_in[4];
    a.w_down = (const float*)d_in[5]; a.conv_w = (const float*)d_in[6]; a.conv_b = (const float*)d_in[7]; a.sinks = (const float*)d_in[8];
    a.pre_mix = (const float*)d_in[9]; a.post_mix = (const float*)d_in[10]; a.attn_norm = (const float*)d_in[11]; a.ret_norm = (const float*)d_in[12];
    a.pre_ffn = (const float*)d_in[13]; a.post_ffn = (const float*)d_in[14];
    a.out = (float*)d_out; a.ws = (unsigned char*)d_ws;
#if MK_SINGLE
    hipMemsetAsync(d_ws, 0, 16384, stream);
    a.ph_lo = 0; a.ph_hi = NPHASES;
    void* kargs[] = {&a};
    hipError_t e = hipLaunchCooperativeKernel((const void*)fwd_kernel, dim3(grid), dim3(NTHREADS), kargs, LDS_BYTES, stream);
    if (e != hipSuccess) fprintf(stderr, "cooperative launch failed: %s (grid %d)\n", hipGetErrorString(e), grid);
#else
    for (int ph = 0; ph < NPHASES; ++ph) { a.ph_lo = ph; a.ph_hi = ph + 1; hipLaunchKernelGGL(fwd_kernel, dim3(grid), dim3(NTHREADS), LDS_BYTES, stream, a); }
#endif
}
```

```cpp
#include <hip/hip_runtime.h>
#include <hip/hip_cooperative_groups.h>
#include <cstdio>
namespace cg = cooperative_groups;

#ifndef MK_SINGLE
#define MK_SINGLE 1
#endif

#ifndef DBG_MASK
#define DBG_MASK 1023
#endif
#define LAS __attribute__((address_space(3)))
#define GAS __attribute__((address_space(1)))
typedef unsigned short bf16_t;
typedef short bf16x8 __attribute__((ext_vector_type(8)));
typedef short s16x4 __attribute__((ext_vector_type(4)));
typedef float f32x4 __attribute__((ext_vector_type(4)));
typedef float f32x16 __attribute__((ext_vector_type(16)));
typedef unsigned u32x4 __attribute__((ext_vector_type(4)));
typedef unsigned u32x2 __attribute__((ext_vector_type(2)));

constexpr int BATCH = 4, SEQ = 4096, DM = 2048, M = BATCH * SEQ, DIN = 5632, DFF = 5632, NUP = 11264, DEPTH = 2;
constexpr int C_QA = 0, C_KA = 1024, C_VA = 1280, C_QR = 1536, C_KR = 2560, C_VR = 3584, C_GR = 4608;
constexpr float EPS = 1e-6f;
constexpr int NTHREADS = 512, NWAVES = 8;
constexpr int LDS_BYTES = 147456;

constexpr size_t MiB = 1u << 20;
constexpr size_t SZ_WIN = (size_t)DIN * DM * 2, SZ_WOUT = (size_t)DM * DM * 2, SZ_WUP = (size_t)NUP * DM * 2, SZ_WDN = (size_t)DM * DFF * 2;
constexpr size_t WS_WIN = 1 * MiB;
constexpr size_t WS_WOUT = WS_WIN + 2 * SZ_WIN;
constexpr size_t WS_WUP = WS_WOUT + 2 * SZ_WOUT;
constexpr size_t WS_WDN = WS_WUP + 2 * SZ_WUP;
constexpr size_t WS_XN = WS_WDN + 2 * SZ_WDN;
constexpr size_t WS_BIG = WS_XN + (size_t)M * DM * 2;
constexpr size_t WS_MIXIN = WS_BIG + (size_t)M * DIN * 2;
constexpr size_t WS_YARAW = WS_MIXIN + (size_t)M * DM * 2;
constexpr size_t WS_STATE = WS_YARAW + (size_t)M * 1024 * 2;
constexpr size_t WS_ROPEA = WS_STATE + (size_t)BATCH * 4 * 32 * 65536 * 2;
constexpr size_t WS_ROPER = WS_ROPEA + (size_t)M * 16 * 4;
constexpr size_t WS_EDGE = WS_ROPER + (size_t)M * 256 * 4;
constexpr size_t WS_XR = WS_EDGE + (size_t)128 * 4 * NUP * 4;
constexpr size_t WS_END = WS_XR + (size_t)M * DM * 2;
static_assert((size_t)M * DM * 4 <= (size_t)M * DM * 2 + (size_t)M * 1024 * 2 + (size_t)BATCH * 4 * 32 * 65536 * 2, "MIX2 overlay");

__device__ __forceinline__ unsigned pk_bf16(float lo, float hi) {
    typedef float f32x2_t __attribute__((ext_vector_type(2)));
    typedef __bf16 bf16x2_t __attribute__((ext_vector_type(2)));
    f32x2_t v = {lo, hi}; bf16x2_t b = __builtin_convertvector(v, bf16x2_t);
    return __builtin_bit_cast(unsigned, b);
}
__device__ __forceinline__ float bf_lo(unsigned u) { return __uint_as_float(u << 16); }
__device__ __forceinline__ float bf_hi(unsigned u) { return __uint_as_float(u & 0xffff0000u); }
__device__ __forceinline__ float wave_sum(float v) {
#pragma unroll
    for (int o = 1; o < 64; o <<= 1) v += __shfl_xor(v, o);
    return v;
}
__device__ __forceinline__ int crow(int r, int h) { return (r & 3) + 8 * (r >> 2) + 4 * h; }
__device__ __forceinline__ bf16x8 pack8(const f32x16& x, int s) {
    u32x4 p;
    p[0] = pk_bf16(x[8 * s + 0], x[8 * s + 1]); p[1] = pk_bf16(x[8 * s + 2], x[8 * s + 3]);
    p[2] = pk_bf16(x[8 * s + 4], x[8 * s + 5]); p[3] = pk_bf16(x[8 * s + 6], x[8 * s + 7]);
    return __builtin_bit_cast(bf16x8, p);
}
#define MFMA32(a, b, c) __builtin_amdgcn_mfma_f32_32x32x16_bf16((a), (b), (c), 0, 0, 0)
__device__ __forceinline__ float gelu_tanh(float a) {
    const float u = a * (2.3022082f + 0.10294324f * a * a);
    return a * __builtin_amdgcn_rcpf(1.0f + __builtin_amdgcn_exp2f(-u));
}
__device__ __forceinline__ float silu_f(float x) { return x * __builtin_amdgcn_rcpf(1.0f + __builtin_amdgcn_exp2f(-1.4426950409f * x)); }

struct Args {
    const float* x; const int* pos; const float* w_in; const float* w_out; const float* w_up; const float* w_down;
    const float* conv_w; const float* conv_b; const float* sinks; const float* pre_mix; const float* post_mix;
    const float* attn_norm; const float* ret_norm; const float* pre_ffn; const float* post_ffn;
    float* out; unsigned char* ws; int ph_lo, ph_hi;
};

template <int CTRL> __device__ __forceinline__ float dpp_ror(float v) { return __builtin_bit_cast(float, __builtin_amdgcn_update_dpp(0, __builtin_bit_cast(int, v), CTRL, 0xf, 0xf, false)); }

namespace pg8 {
constexpr int BM = 256, BK = 64, HALF = 128, HTB = HALF * BK * 2, STAGE_BYTES = 8 * HTB, NXCD = 8, WGM = 8;
__device__ __forceinline__ int lds_byte(int r, int c) { const int st = (r >> 4) * 2 + (c >> 5), rr = r & 15, cc = c & 31, ob = rr * 64 + cc * 2; return st * 1024 + (ob ^ (((ob >> 9) & 1) << 5)); }
__device__ __forceinline__ void stage_rc(int b, int& R, int& C) { const int st = b / 1024, sb = b % 1024, swz = sb ^ (((sb >> 9) & 1) << 5); R = (st >> 1) * 16 + swz / 64; C = (st & 1) * 32 + (swz % 64) / 2; }
__device__ __forceinline__ int perm32(int rho) { const int n = rho >> 4, i = rho & 15; return 8 * (i >> 2) + 4 * n + (i & 3); }
struct Unit { int pm, pn; };
struct Gemm { const bf16_t* A; const bf16_t* Bt; int M, N, K; };
struct StaticOrder {
    int nM, nN, nwg, G, c;
    __device__ void init(int M_, int N_, int G_, int c_) { nM = M_ / BM; nN = N_ / BM; nwg = nM * nN; G = G_; c = c_; }
    __device__ bool next(int i, Unit& u) const {
        const long L = (long)i * G + c; if (L >= nwg) return false;
        int wgid = (int)L; { const int q = nwg / NXCD, r = nwg % NXCD, xcd = wgid % NXCD, off = wgid / NXCD; wgid = (xcd < r ? xcd * (q + 1) : r * (q + 1) + (xcd - r) * q) + off; }
        const int nig = WGM * nN, gid = wgid / nig, fm = gid * WGM, gsz = (nM - fm) < WGM ? (nM - fm) : WGM;
        u.pm = fm + ((wgid % nig) % gsz); u.pn = (wgid % nig) / gsz; return true;
    }
};

#ifndef PG8_ALIGN
#define PG8_ALIGN true
#endif
#ifndef PG8_SP2
#define PG8_SP2 true
#endif
template <class Epi, bool ALIGN_EPI = PG8_ALIGN, bool SP2 = PG8_SP2>
__device__ __forceinline__ void gemm_phase(LAS unsigned char* lds, const Gemm g, const StaticOrder& S, const Epi& E, const int tid) {
    const int wid = __builtin_amdgcn_readfirstlane(tid >> 6), lane = tid & 63, wr = wid >> 2, wc = wid & 3, fr = lane & 15, fq = lane >> 4;
    const int K = g.K, nt = K / BK;
    unsigned voffA[2], voffB[2];
#pragma unroll
    for (int i = 0; i < 2; ++i) { int R, C; stage_rc(tid * 16 + i * 8192, R, C); const int Rb = Epi::PERM ? ((R & ~31) + perm32(R & 31)) : R;
        const int Ra = Epi::AROWPERM ? (128 * (R >> 6) + 8 * (R & 15) + ((R >> 4) & 3)) : R;
        voffA[i] = (unsigned)(Ra * K + C) * 2u; voffB[i] = (unsigned)(Rb * K + C) * 2u; }
    const size_t kstep = (size_t)(BK * 2);
    const size_t hstepB = (size_t)HALF * K * 2;
    const size_t hstepA = Epi::AROWPERM ? (size_t)4 * K * 2 : (size_t)HALF * K * 2;
    const size_t tstep = (size_t)BM * K * 2;
    const unsigned ldsw = (unsigned)wid * 1024u;
    const int aoff = lds_byte(wr * 64 + fr, fq * 8), boff = lds_byte(wc * 32 + fr, fq * 8);
#define PG8_SA(b, h) (((b) * 2 + (h)) * HTB)
#define PG8_SB(b, h) ((4 + (b) * 2 + (h)) * HTB)
#define PG8_STAGE(bufoff, gbase, voff) do { _Pragma("unroll") for (int _i = 0; _i < 2; ++_i) \
        __builtin_amdgcn_global_load_lds((const unsigned*)((const char*)(gbase) + (voff)[_i]), (LAS unsigned*)(lds + (bufoff) + ldsw + _i * 8192), 16, 0, 0); } while (0)
#define PG8_LDA(dst, b, h) do { _Pragma("unroll") for (int m = 0; m < 4; ++m) _Pragma("unroll") for (int k = 0; k < 2; ++k) dst[m][k] = *(const LAS bf16x8*)(lds + PG8_SA(b, h) + aoff + m * 2048 + k * 1024); } while (0)
#define PG8_LDB(dst, b, h) do { _Pragma("unroll") for (int n = 0; n < 2; ++n) _Pragma("unroll") for (int k = 0; k < 2; ++k) dst[n][k] = *(const LAS bf16x8*)(lds + PG8_SB(b, h) + boff + n * 2048 + k * 1024); } while (0)
#define PG8_MMA(ai, bj, At, Bt) do { __builtin_amdgcn_s_setprio(1); _Pragma("unroll") for (int m = 0; m < 4; ++m) _Pragma("unroll") for (int n = 0; n < 2; ++n) _Pragma("unroll") for (int k = 0; k < 2; ++k) \
        acc[ai][bj][m][n] = __builtin_amdgcn_mfma_f32_16x16x32_bf16(Bt[n][k], At[m][k], acc[ai][bj][m][n], 0, 0, 0); __builtin_amdgcn_s_setprio(0); } while (0)
#define PG8_WAIT_V(n) asm volatile("s_waitcnt vmcnt(" #n ")" ::: "memory")
#define PG8_WAIT_L(n) asm volatile("s_waitcnt lgkmcnt(" #n ")" ::: "memory")
#define PG8_BAR __builtin_amdgcn_s_barrier()
#define PG8_SCHED __builtin_amdgcn_sched_barrier(0)
    Unit cur, nxt; int ui = 0;
    if (!S.next(0, cur)) return;
    f32x4 acc[2][2][4][2];
#pragma unroll
    for (int a = 0; a < 2; ++a)
#pragma unroll
        for (int b = 0; b < 2; ++b)
#pragma unroll
            for (int m = 0; m < 4; ++m)
#pragma unroll
                for (int n = 0; n < 2; ++n) acc[a][b][m][n] = (f32x4){0.f, 0.f, 0.f, 0.f};
    bf16x8 At[4][2], B0[2][2], B1[2][2];
    const char* cA = (const char*)g.A + (size_t)cur.pm * tstep; const char* cB = (const char*)g.Bt + (size_t)cur.pn * tstep;
    typename Epi::Pre pre = E.prefetch(cur, wr, wc, lane);
    if constexpr (SP2) {
        PG8_STAGE(PG8_SB(0, 0), cB, voffB); PG8_STAGE(PG8_SB(0, 1), cB + hstepB, voffB); PG8_STAGE(PG8_SA(0, 0), cA, voffA); PG8_STAGE(PG8_SA(0, 1), cA + hstepA, voffA);
        if (wr == 1) PG8_BAR;
        PG8_WAIT_V(2); PG8_BAR;
        PG8_STAGE(PG8_SB(1, 0), cB + kstep, voffB); PG8_STAGE(PG8_SA(1, 0), cA + kstep, voffA); PG8_STAGE(PG8_SB(1, 1), cB + hstepB + kstep, voffB);
        PG8_WAIT_V(6); PG8_BAR;
    } else {
    PG8_STAGE(PG8_SB(0, 0), cB, voffB); PG8_STAGE(PG8_SA(0, 0), cA, voffA); PG8_STAGE(PG8_SB(0, 1), cB + hstepB, voffB); PG8_STAGE(PG8_SA(0, 1), cA + hstepA, voffA);
    if (wr == 1) PG8_BAR;
    PG8_WAIT_V(4); PG8_BAR;
    PG8_STAGE(PG8_SB(1, 0), cB + kstep, voffB); PG8_STAGE(PG8_SA(1, 0), cA + kstep, voffA); PG8_STAGE(PG8_SB(1, 1), cB + hstepB + kstep, voffB);
    PG8_WAIT_V(6); PG8_BAR;
    }
    for (;;) {
        const bool has_next = S.next(ui + 1, nxt);
        const char* nA = has_next ? (const char*)g.A + (size_t)nxt.pm * tstep : cA; const char* nB = has_next ? (const char*)g.Bt + (size_t)nxt.pn * tstep : cB;
        for (int t = 0; t < nt; t += 2) {
            const bool last = (t == nt - 2);
            const char* a1 = cA + (size_t)(t + 1) * kstep;
            const char* a2 = last ? nA : cA + (size_t)(t + 2) * kstep; const char* b2 = last ? nB : cB + (size_t)(t + 2) * kstep;
            const char* a3 = a2 + kstep; const char* b3 = b2 + kstep;
            if constexpr (SP2) {
            PG8_LDB(B0, 0, 0); PG8_LDB(B1, 0, 1); PG8_SCHED; PG8_LDA(At, 0, 0); PG8_STAGE(PG8_SA(1, 1), a1 + hstepA, voffA);
            PG8_WAIT_V(8); PG8_WAIT_L(0); PG8_BAR; PG8_MMA(0, 0, At, B0); PG8_MMA(0, 1, At, B1); PG8_BAR; PG8_SCHED;
            PG8_LDA(At, 0, 1); PG8_STAGE(PG8_SB(0, 0), b2, voffB); PG8_STAGE(PG8_SB(0, 1), b2 + hstepB, voffB); PG8_STAGE(PG8_SA(0, 0), a2, voffA);
            PG8_WAIT_V(8); PG8_WAIT_L(0); PG8_BAR; PG8_MMA(1, 0, At, B0); PG8_MMA(1, 1, At, B1); PG8_BAR; PG8_SCHED;
            PG8_LDB(B0, 1, 0); PG8_LDB(B1, 1, 1); PG8_SCHED; PG8_LDA(At, 1, 0); PG8_STAGE(PG8_SA(0, 1), a2 + hstepA, voffA);
            PG8_WAIT_V(8); PG8_WAIT_L(0); PG8_BAR; PG8_MMA(0, 0, At, B0); PG8_MMA(0, 1, At, B1); PG8_BAR; PG8_SCHED;
            PG8_LDA(At, 1, 1); PG8_STAGE(PG8_SB(1, 0), b3, voffB); PG8_STAGE(PG8_SB(1, 1), b3 + hstepB, voffB); PG8_STAGE(PG8_SA(1, 0), a3, voffA);
            PG8_WAIT_V(8); PG8_WAIT_L(0); PG8_BAR; PG8_MMA(1, 0, At, B0); PG8_MMA(1, 1, At, B1); PG8_BAR; PG8_SCHED;
            } else {
            PG8_LDB(B0, 0, 0); PG8_SCHED; PG8_LDA(At, 0, 0); PG8_STAGE(PG8_SA(1, 1), a1 + hstepA, voffA);
            PG8_WAIT_L(8); PG8_BAR; PG8_WAIT_L(0); PG8_MMA(0, 0, At, B0); PG8_BAR; PG8_SCHED;
            PG8_LDB(B1, 0, 1); PG8_STAGE(PG8_SB(0, 0), b2, voffB);
            PG8_BAR; PG8_WAIT_L(0); PG8_MMA(0, 1, At, B1); PG8_BAR;
            PG8_LDA(At, 0, 1); PG8_STAGE(PG8_SA(0, 0), a2, voffA);
            PG8_BAR; PG8_WAIT_L(0); PG8_MMA(1, 0, At, B0); PG8_BAR; PG8_SCHED;
            PG8_STAGE(PG8_SB(0, 1), b2 + hstepB, voffB);
            PG8_WAIT_V(6); PG8_BAR; PG8_MMA(1, 1, At, B1); PG8_BAR;
            PG8_LDB(B0, 1, 0); PG8_SCHED; PG8_LDA(At, 1, 0); PG8_STAGE(PG8_SA(0, 1), a2 + hstepA, voffA);
            PG8_WAIT_L(8); PG8_BAR; PG8_WAIT_L(0); PG8_MMA(0, 0, At, B0); PG8_BAR; PG8_SCHED;
            PG8_LDB(B1, 1, 1); PG8_STAGE(PG8_SB(1, 0), b3, voffB);
            PG8_BAR; PG8_WAIT_L(0); PG8_MMA(0, 1, At, B1); PG8_BAR;
            PG8_LDA(At, 1, 1); PG8_STAGE(PG8_SA(1, 0), a3, voffA);
            PG8_BAR; PG8_WAIT_L(0); PG8_MMA(1, 0, At, B0); PG8_BAR; PG8_SCHED;
            PG8_STAGE(PG8_SB(1, 1), b3 + hstepB, voffB);
            PG8_WAIT_V(6); PG8_BAR; PG8_MMA(1, 1, At, B1); PG8_BAR;
            }
        }
        if constexpr (ALIGN_EPI) { if (wr == 0) PG8_BAR; }
        E(acc, cur, wr, wc, fr, fq, pre, lds);
        if (!has_next) break;
        pre = E.prefetch(nxt, wr, wc, lane);
#pragma unroll
        for (int a = 0; a < 2; ++a)
#pragma unroll
            for (int b = 0; b < 2; ++b)
#pragma unroll
                for (int m = 0; m < 4; ++m)
#pragma unroll
                    for (int n = 0; n < 2; ++n) acc[a][b][m][n] = (f32x4){0.f, 0.f, 0.f, 0.f};
        cur = nxt; cA = nA; cB = nB; ++ui;
        if constexpr (ALIGN_EPI) { if (wr == 1) PG8_BAR; }
    }
    PG8_WAIT_V(0);
    if constexpr (!ALIGN_EPI) { if (wr == 0) PG8_BAR; }
    PG8_BAR;
#undef PG8_SA
#undef PG8_SB
#undef PG8_STAGE
#undef PG8_LDA
#undef PG8_LDB
#undef PG8_MMA
#undef PG8_WAIT_V
#undef PG8_WAIT_L
#undef PG8_BAR
#undef PG8_SCHED
}

struct EpiF32 {
    static constexpr bool PERM = false, AROWPERM = false;
    float* C; int ldc;
    struct Pre {};
    __device__ __forceinline__ Pre prefetch(const Unit&, int, int, int) const { return Pre{}; }
    __device__ __forceinline__ void operator()(const f32x4 (&acc)[2][2][4][2], const Unit& u, int wr, int wc, int fr, int fq, const Pre&, LAS unsigned char*) const {
        const int row0 = u.pm * BM + wr * 64 + fr, col0 = u.pn * BM + wc * 32 + 4 * fq;
#pragma unroll
        for (int ai = 0; ai < 2; ++ai)
#pragma unroll
            for (int m = 0; m < 4; ++m) { float* rowp = C + (size_t)(row0 + ai * HALF + m * 16) * ldc + col0;
#pragma unroll
                for (int bj = 0; bj < 2; ++bj)
#pragma unroll
                    for (int n = 0; n < 2; ++n) *(f32x4*)(rowp + bj * HALF + n * 16) = acc[ai][bj][m][n]; }
    }
};

struct EpiBf16 {
    static constexpr bool PERM = true, AROWPERM = false;
    bf16_t* O; int ldc;
    struct Pre {};
    __device__ __forceinline__ Pre prefetch(const Unit&, int, int, int) const { return Pre{}; }
    __device__ __forceinline__ void operator()(const f32x4 (&acc)[2][2][4][2], const Unit& u, int wr, int wc, int fr, int fq, const Pre&, LAS unsigned char*) const {
        const int row0 = u.pm * BM + wr * 64 + fr, col0 = u.pn * BM + wc * 32 + 8 * fq;
#pragma unroll
        for (int ai = 0; ai < 2; ++ai)
#pragma unroll
            for (int m = 0; m < 4; ++m) { bf16_t* rowp = O + (size_t)(row0 + ai * HALF + m * 16) * ldc + col0;
#pragma unroll
                for (int bj = 0; bj < 2; ++bj) { const f32x4 v0 = acc[ai][bj][m][0], v1 = acc[ai][bj][m][1];
                    u32x4 w; w.x = pk_bf16(v0[0], v0[1]); w.y = pk_bf16(v0[2], v0[3]); w.z = pk_bf16(v1[0], v1[1]); w.w = pk_bf16(v1[2], v1[3]);
                    *(u32x4*)(rowp + bj * HALF) = w; } }
    }
};

struct EpiProj {
    static constexpr bool PERM = true, AROWPERM = false;
    bf16_t* O; const float* ropeA; const float* ropeR;
    struct Pre {};
    __device__ __forceinline__ Pre prefetch(const Unit&, int, int, int) const { return Pre{}; }
    __device__ __forceinline__ void operator()(f32x4 (&acc)[2][2][4][2], const Unit& u, int wr, int wc, int fr, int fq, const Pre&, LAS unsigned char*) const {
        const int pn = u.pn;
        const int rbase = u.pm * BM + wr * 64 + fr;
        const int cbase = pn * BM + wc * 32 + 8 * fq;
        if (pn <= 4) {
            const float sc = pn < 4 ? 0.125f : 1.0f;
            const bool ropew = (wc & 1) == 0;
#pragma unroll
            for (int ai = 0; ai < 2; ++ai)
#pragma unroll
                for (int m = 0; m < 4; ++m) {
                    const int row = rbase + ai * HALF + m * 16;
                    if (ropew) {
                        const f32x4* tp = (const f32x4*)(ropeA + (size_t)row * 16);
                        const f32x4 cs[2] = {tp[0], tp[1]}; const f32x4 sn[2] = {tp[2], tp[3]};
#pragma unroll
                        for (int bj = 0; bj < 2; ++bj)
#pragma unroll
                            for (int n = 0; n < 2; ++n)
#pragma unroll
                                for (int j = 0; j < 4; ++j) {
                                    const float own = acc[ai][bj][m][n][j]; const float par = __shfl_xor(own, 16);
                                    const float c = cs[n][j], s = sn[n][j];
                                    const float r0 = own * c - par * s, r1 = own * c + par * s;
                                    acc[ai][bj][m][n][j] = (fq == 0) ? r0 : ((fq == 1) ? r1 : own);
                                }
                    }
#pragma unroll
                    for (int bj = 0; bj < 2; ++bj) {
                        const f32x4 v0 = acc[ai][bj][m][0] * sc, v1 = acc[ai][bj][m][1] * sc;
                        u32x4 w; w.x = pk_bf16(v0[0], v0[1]); w.y = pk_bf16(v0[2], v0[3]); w.z = pk_bf16(v1[0], v1[1]); w.w = pk_bf16(v1[2], v1[3]);
                        *(u32x4*)(O + (size_t)row * DIN + cbase + bj * HALF) = w;
                    }
                }
        } else if (pn >= 6 && pn <= 13) {
            const int h = (pn - 6) & 3; const bool isK = pn >= 10;
            const float lg2 = __log2f(1.0f - exp2f(-5.0f - (float)h));
            const int i0 = wc * 32 + 8 * fq;
#pragma unroll
            for (int ai = 0; ai < 2; ++ai)
#pragma unroll
                for (int m = 0; m < 4; ++m) {
                    const int row = rbase + ai * HALF + m * 16;
                    const float p = (float)((row & 127) + 1);
                    const float dec = isK ? 0.0625f * exp2f(-p * lg2) : exp2f(p * lg2);
                    const f32x4* tc = (const f32x4*)(ropeR + (size_t)row * 256 + i0);
                    const f32x4* ts = (const f32x4*)(ropeR + (size_t)row * 256 + 128 + i0);
                    const f32x4 cs[2] = {tc[0], tc[1]}; const f32x4 sn[2] = {ts[0], ts[1]};
#pragma unroll
                    for (int n = 0; n < 2; ++n) {
                        const f32x4 x1 = acc[ai][0][m][n], x2 = acc[ai][1][m][n];
                        acc[ai][0][m][n] = (x1 * cs[n] - x2 * sn[n]) * dec;
                        acc[ai][1][m][n] = (x2 * cs[n] + x1 * sn[n]) * dec;
                    }
#pragma unroll
                    for (int bj = 0; bj < 2; ++bj) {
                        const f32x4 v0 = acc[ai][bj][m][0], v1 = acc[ai][bj][m][1];
                        u32x4 w; w.x = pk_bf16(v0[0], v0[1]); w.y = pk_bf16(v0[2], v0[3]); w.z = pk_bf16(v1[0], v1[1]); w.w = pk_bf16(v1[2], v1[3]);
                        *(u32x4*)(O + (size_t)row * DIN + cbase + bj * HALF) = w;
                    }
                }
        } else {
            const bool gate = pn >= 18;
#pragma unroll
            for (int ai = 0; ai < 2; ++ai)
#pragma unroll
                for (int m = 0; m < 4; ++m) {
                    const int row = rbase + ai * HALF + m * 16;
#pragma unroll
                    for (int bj = 0; bj < 2; ++bj) {
                        f32x4 v0 = acc[ai][bj][m][0], v1 = acc[ai][bj][m][1];
                        if (gate) {
#pragma unroll
                            for (int j = 0; j < 4; ++j) { v0[j] = silu_f(v0[j]); v1[j] = silu_f(v1[j]); }
                        }
                        u32x4 w; w.x = pk_bf16(v0[0], v0[1]); w.y = pk_bf16(v0[2], v0[3]); w.z = pk_bf16(v1[0], v1[1]); w.w = pk_bf16(v1[2], v1[3]);
                        *(u32x4*)(O + (size_t)row * DIN + cbase + bj * HALF) = w;
                    }
                }
        }
    }
};

struct EpiUpConv {
    static constexpr bool PERM = true, AROWPERM = true;
    bf16_t* ACT; float* EDGE; const float* cw; const float* cb; const float* RS;
    struct Pre { f32x4 c, r0, r1; };
    __device__ __forceinline__ Pre prefetch(const Unit& u, int wr, int wc, int lane) const {
        const int k = lane >> 4, part = (lane >> 3) & 1, c = 4 * (lane & 7);
        const float* p = (k < 3 ? cw + (size_t)k * NUP : cb) + part * DFF + u.pn * 128 + wc * 32 + c;
        const float* r = RS + u.pm * BM + wr * HALF + 8 * (lane & 15);
        Pre P; P.c = *(const f32x4*)p; P.r0 = *(const f32x4*)r; P.r1 = *(const f32x4*)(r + 4); return P;
    }
    __device__ __forceinline__ void operator()(f32x4 (&acc)[2][2][4][2], const Unit& u, int wr, int wc, int fr, int fq, const Pre& pre, LAS unsigned char* lds) const {
        const int lane = fq * 16 + fr;
        LAS float* wl = (LAS float*)(lds + STAGE_BYTES + (wr * 4 + wc) * 1024);
        *(LAS f32x4*)(wl + 4 * lane) = pre.c;
#pragma unroll
        for (int gi = 0; gi < 8; ++gi) { const float rsv = gi < 4 ? pre.r0[gi & 3] : pre.r1[gi & 3];
#pragma unroll
            for (int bj = 0; bj < 2; ++bj)
#pragma unroll
                for (int n = 0; n < 2; ++n) acc[gi >> 2][bj][gi & 3][n] *= rsv; }
        const int rowh = u.pm * BM + wr * HALF;
        const int hidx = rowh >> 7;
#pragma unroll
        for (int n = 0; n < 2; ++n) {
            const int ca = u.pn * 128 + wc * 32 + 8 * fq + 4 * n;
            const LAS float* wq = wl + 8 * fq + 4 * n;
            const f32x4 wa0 = *(const LAS f32x4*)(wq), wa1 = *(const LAS f32x4*)(wq + 64), wa2 = *(const LAS f32x4*)(wq + 128), ba = *(const LAS f32x4*)(wq + 192);
            const f32x4 wg0 = *(const LAS f32x4*)(wq + 32), wg1 = *(const LAS f32x4*)(wq + 96), wg2 = *(const LAS f32x4*)(wq + 160), bg = *(const LAS f32x4*)(wq + 224);
            const f32x4 a6 = acc[1][0][2][n], a7 = acc[1][0][3][n], g6 = acc[1][1][2][n], g7 = acc[1][1][3][n];
            f32x4 pa6, pa7, pg6, pg7;
#pragma unroll
            for (int j = 0; j < 4; ++j) { pa6[j] = dpp_ror<0x121>(a6[j]); pa7[j] = dpp_ror<0x121>(a7[j]); pg6[j] = dpp_ror<0x121>(g6[j]); pg7[j] = dpp_ror<0x121>(g7[j]); }
#pragma unroll
            for (int gi = 0; gi < 8; ++gi) {
                const f32x4 a = acc[gi >> 2][0][gi & 3][n], g = acc[gi >> 2][1][gi & 3][n];
                const f32x4 am1 = gi >= 1 ? acc[(gi - 1 + 8) % 8 >> 2][0][(gi - 1 + 8) % 8 & 3][n] : pa7;
                const f32x4 gm1 = gi >= 1 ? acc[(gi - 1 + 8) % 8 >> 2][1][(gi - 1 + 8) % 8 & 3][n] : pg7;
                const f32x4 am2 = gi >= 2 ? acc[(gi - 2 + 8) % 8 >> 2][0][(gi - 2 + 8) % 8 & 3][n] : (gi == 1 ? pa7 : pa6);
                const f32x4 gm2 = gi >= 2 ? acc[(gi - 2 + 8) % 8 >> 2][1][(gi - 2 + 8) % 8 & 3][n] : (gi == 1 ? pg7 : pg6);
                const f32x4 ua = wa0 * am2 + wa1 * am1 + wa2 * a + ba;
                const f32x4 ug = wg0 * gm2 + wg1 * gm1 + wg2 * g + bg;
                const int row = rowh + 8 * fr + gi;
                if (!(gi < 2 && fr == 0)) {
                    u32x2 w; w.x = pk_bf16(gelu_tanh(ua[0]) * ug[0], gelu_tanh(ua[1]) * ug[1]); w.y = pk_bf16(gelu_tanh(ua[2]) * ug[2], gelu_tanh(ua[3]) * ug[3]);
                    *(u32x2*)(ACT + (size_t)row * DFF + ca) = w;
                }
                if (gi < 2 && fr == 0) { float* e = EDGE + (size_t)(hidx * 4 + gi) * NUP; *(f32x4*)(e + ca) = a; *(f32x4*)(e + DFF + ca) = g; }
                if (gi >= 6 && fr == 15) { float* e = EDGE + (size_t)(hidx * 4 + gi - 4) * NUP; *(f32x4*)(e + ca) = a; *(f32x4*)(e + DFF + ca) = g; }
            }
        }
    }
};
}

typedef const Args __attribute__((address_space(4)))* KArgs;
struct Frame {
    LAS unsigned char* lds;
    int tid, lane, wave, G, bid;
    KArgs ka;
    GAS unsigned char* ws;
};
#define WSP(T, off) ((T*)(F.ws + (off)))
#define P_WinT  WSP(bf16_t, WS_WIN)
#define P_WoutT WSP(bf16_t, WS_WOUT)
#define P_WupT  WSP(bf16_t, WS_WUP)
#define P_WdnT  WSP(bf16_t, WS_WDN)
#define P_XN    WSP(bf16_t, WS_XN)
#define P_RS    WSP(float, 65536)
#define P_PROJ  WSP(bf16_t, WS_BIG)
#define P_ACT   WSP(bf16_t, WS_BIG)
#define P_MIX   WSP(float, WS_BIG)
#define P_MIXB  WSP(bf16_t, WS_BIG)
#define P_MIX2B WSP(bf16_t, WS_MIXIN)
#define P_MIXIN WSP(bf16_t, WS_MIXIN)
#define P_MIX2  WSP(float, WS_MIXIN)
#define P_YARAW WSP(bf16_t, WS_YARAW)
#define P_STATE WSP(bf16_t, WS_STATE)
#define P_ROPEA WSP(float, WS_ROPEA)
#define P_ROPER WSP(float, WS_ROPER)
#define P_EDGE  WSP(float, WS_EDGE)
#define P_XR    WSP(bf16_t, WS_XR)

__device__ __forceinline__ void transpose_item(const float* W, int K, int N, bf16_t* WT, int k0, int n0, int drow0, LAS float* scr, int lane, const float* gain = nullptr) {
    const float gl = gain ? gain[k0 + lane] : 1.0f;
#pragma unroll 8
    for (int i = 0; i < 64; ++i) scr[i * 65 + lane] = W[(size_t)(k0 + i) * N + n0 + lane] * __builtin_bit_cast(float, __builtin_amdgcn_readlane(__builtin_bit_cast(int, gl), i));
    asm volatile("s_waitcnt lgkmcnt(0)" ::: "memory");
    const int c = lane & 7;
#pragma unroll
    for (int j = 0; j < 8; ++j) { const int n = (lane >> 3) + 8 * j; const LAS float* s = scr + (8 * c) * 65 + n;
        u32x4 o; o.x = pk_bf16(s[0 * 65], s[1 * 65]); o.y = pk_bf16(s[2 * 65], s[3 * 65]); o.z = pk_bf16(s[4 * 65], s[5 * 65]); o.w = pk_bf16(s[6 * 65], s[7 * 65]);
        *(u32x4*)(WT + (size_t)(drow0 + n) * K + k0 + 8 * c) = o; }
    asm volatile("s_waitcnt lgkmcnt(0)" ::: "memory");
}
__device__ __forceinline__ void p0_prologue(Frame& F) {
    LAS float* scr = (LAS float*)(F.lds + F.wave * 16640);
    const int gw = F.bid * NWAVES + F.wave, NGW = F.G * NWAVES;
    constexpr int I_IN = (DM / 64) * (DIN / 64), I_OUT = (DM / 64) * (DM / 64), I_UP = (DM / 64) * (NUP / 64), I_DN = (DFF / 64) * (DM / 64);
    constexpr int PER_L = I_IN + I_OUT + I_UP + I_DN;
    for (int it = gw; it < DEPTH * PER_L; it += NGW) {
        const int l = it / PER_L; int r = it % PER_L;
        if (r < I_IN) { const int nb = DIN / 64, kb = r / nb, n0 = 64 * (r % nb); transpose_item(((const float*)(GAS const float*)F.ka->w_in) + (size_t)l * DM * DIN, DM, DIN, P_WinT + (size_t)l * DIN * DM, 64 * kb, n0, n0, scr, F.lane); continue; } r -= I_IN;
        if (r < I_OUT) { const int nb = DM / 64, kb = r / nb, n0 = 64 * (r % nb); transpose_item(((const float*)(GAS const float*)F.ka->w_out) + (size_t)l * DM * DM, DM, DM, P_WoutT + (size_t)l * DM * DM, 64 * kb, n0, n0, scr, F.lane); continue; } r -= I_OUT;
        if (r < I_UP) { const int nb = NUP / 64, kb = r / nb, n0 = 64 * (r % nb);
            const int bj = n0 >= DFF ? 1 : 0, cc = n0 - bj * DFF, drow = 256 * (cc >> 7) + 128 * bj + (cc & 127);
            transpose_item(((const float*)(GAS const float*)F.ka->w_up) + (size_t)l * DM * NUP, DM, NUP, P_WupT + (size_t)l * NUP * DM, 64 * kb, n0, drow, scr, F.lane, ((const float*)(GAS const float*)F.ka->pre_ffn) + (size_t)l * DM); continue; } r -= I_UP;
        { const int nb = DM / 64, kb = r / nb, n0 = 64 * (r % nb); transpose_item(((const float*)(GAS const float*)F.ka->w_down) + (size_t)l * DFF * DM, DFF, DM, P_WdnT + (size_t)l * DM * DFF, 64 * kb, n0, n0, scr, F.lane); }
    }
    const int gt = F.bid * NTHREADS + F.tid, NGT = F.G * NTHREADS;
    for (int i = gt; i < M * 8; i += NGT) { const int m = i >> 3, f = i & 7;
        const float inv = powf(500000.0f, -(float)f / 8.0f);
        const double rev = (double)((const int*)(GAS const int*)F.ka->pos)[m] * (double)inv * 0.15915494309189535; const float fr = (float)(rev - floor(rev));
        P_ROPEA[(size_t)m * 16 + f] = __builtin_amdgcn_cosf(fr); P_ROPEA[(size_t)m * 16 + 8 + f] = __builtin_amdgcn_sinf(fr); }
    for (int i = gt; i < M * 128; i += NGT) { const int m = i >> 7, f = i & 127;
        const float inv = powf(10000.0f, -(float)f / 128.0f);
        const double rev = (double)((const int*)(GAS const int*)F.ka->pos)[m] * (double)inv * 0.15915494309189535; const float fr = (float)(rev - floor(rev));
        P_ROPER[(size_t)m * 256 + f] = __builtin_amdgcn_cosf(fr); P_ROPER[(size_t)m * 256 + 128 + f] = __builtin_amdgcn_sinf(fr); }
    for (int m = gw; m < M; m += NGW) {
        const f32x4* xr = (const f32x4*)(((const float*)(GAS const float*)F.ka->x) + (size_t)m * DM) + F.lane; f32x4 v[8]; float ss = 0.f;
#pragma unroll
        for (int j = 0; j < 8; ++j) { v[j] = xr[64 * j]; ss += (v[j].x * v[j].x + v[j].y * v[j].y) + (v[j].z * v[j].z + v[j].w * v[j].w); }
        const float rs = rsqrtf(wave_sum(ss) * (1.0f / DM) + EPS);
        u32x2* o = (u32x2*)(P_XN + (size_t)m * DM) + F.lane; const f32x4* wn = (const f32x4*)((const float*)(GAS const float*)F.ka->pre_mix) + F.lane;
#pragma unroll
        for (int j = 0; j < 8; ++j) { const f32x4 w = wn[64 * j]; u32x2 p; p.x = pk_bf16(v[j].x * rs * w.x, v[j].y * rs * w.y); p.y = pk_bf16(v[j].z * rs * w.z, v[j].w * rs * w.w); o[64 * j] = p; }
    }
}

template <bool XI_F32, bool XO_F32>
__device__ __forceinline__ void rowpass(Frame& F, const void* xi_, const bf16_t* mix, const float* wpost, const float* wnext, void* xo_, int do_xn) {
    const int gw = F.bid * NWAVES + F.wave, NGW = F.G * NWAVES;
    u32x4 mv[4]; f32x4 xv[4][2];
    auto ldx = [&](int m, int j, f32x4& a, f32x4& b2) {
        const int c8 = 8 * (F.lane + 64 * j);
        if (XI_F32) { const float* p = (const float*)xi_ + (size_t)m * DM + c8; a = __builtin_nontemporal_load((const f32x4*)p); b2 = __builtin_nontemporal_load((const f32x4*)(p + 4)); }
        else { const u32x4 r = __builtin_nontemporal_load((const u32x4*)((const bf16_t*)xi_ + (size_t)m * DM + c8));
               a = (f32x4){bf_lo(r.x), bf_hi(r.x), bf_lo(r.y), bf_hi(r.y)}; b2 = (f32x4){bf_lo(r.z), bf_hi(r.z), bf_lo(r.w), bf_hi(r.w)}; }
    };
    f32x4 wpv[4][2], wnv[4][2];
#pragma unroll
    for (int j = 0; j < 4; ++j) { const int c8 = 8 * (F.lane + 64 * j); wpv[j][0] = *(const f32x4*)(wpost + c8); wpv[j][1] = *(const f32x4*)(wpost + c8 + 4); wnv[j][0] = *(const f32x4*)(wnext + c8); wnv[j][1] = *(const f32x4*)(wnext + c8 + 4); }
    int m = gw;
    if (m < M) {
#pragma unroll
        for (int j = 0; j < 4; ++j) { mv[j] = __builtin_nontemporal_load((const u32x4*)(mix + (size_t)m * DM + 8 * (F.lane + 64 * j))); ldx(m, j, xv[j][0], xv[j][1]); }
    }
    while (m < M) {
        const int mn = m + NGW;
        u32x4 nmv[4]; f32x4 nxv[4][2];
        if (mn < M) {
#pragma unroll
            for (int j = 0; j < 4; ++j) { nmv[j] = __builtin_nontemporal_load((const u32x4*)(mix + (size_t)mn * DM + 8 * (F.lane + 64 * j))); ldx(mn, j, nxv[j][0], nxv[j][1]); }
        } else {
#pragma unroll
            for (int j = 0; j < 4; ++j) { nmv[j] = mv[j]; nxv[j][0] = xv[j][0]; nxv[j][1] = xv[j][1]; }
        }
        f32x4 v[4][2]; float ss = 0.f;
#pragma unroll
        for (int j = 0; j < 4; ++j) {
            v[j][0] = (f32x4){bf_lo(mv[j].x), bf_hi(mv[j].x), bf_lo(mv[j].y), bf_hi(mv[j].y)}; v[j][1] = (f32x4){bf_lo(mv[j].z), bf_hi(mv[j].z), bf_lo(mv[j].w), bf_hi(mv[j].w)};
#pragma unroll
            for (int q = 0; q < 2; ++q) ss += (v[j][q].x * v[j][q].x + v[j][q].y * v[j][q].y) + (v[j][q].z * v[j][q].z + v[j][q].w * v[j][q].w);
        }
        const float rs = rsqrtf(wave_sum(ss) * (1.0f / DM) + EPS);
        float s2 = 0.f;
#pragma unroll
        for (int j = 0; j < 4; ++j) { const int c8 = 8 * (F.lane + 64 * j);
#pragma unroll
            for (int q = 0; q < 2; ++q) { const f32x4 y = xv[j][q] + v[j][q] * rs * wpv[j][q]; v[j][q] = y;
                s2 += (y.x * y.x + y.y * y.y) + (y.z * y.z + y.w * y.w); }
            if (XO_F32) { float* p = (float*)xo_ + (size_t)m * DM + c8; __builtin_nontemporal_store(v[j][0], (f32x4*)p); __builtin_nontemporal_store(v[j][1], (f32x4*)(p + 4)); }
            else { u32x4 p; p.x = pk_bf16(v[j][0].x, v[j][0].y); p.y = pk_bf16(v[j][0].z, v[j][0].w); p.z = pk_bf16(v[j][1].x, v[j][1].y); p.w = pk_bf16(v[j][1].z, v[j][1].w);
                   *(u32x4*)((bf16_t*)xo_ + (size_t)m * DM + c8) = p; }
        }
        if (do_xn == 2) { const float rs2 = rsqrtf(wave_sum(s2) * (1.0f / DM) + EPS); if (F.lane == 0) P_RS[m] = rs2; }
        if (do_xn == 1) {
            const float rs2 = rsqrtf(wave_sum(s2) * (1.0f / DM) + EPS);
#pragma unroll
            for (int j = 0; j < 4; ++j) { const int c8 = 8 * (F.lane + 64 * j); const f32x4 w0 = wnv[j][0], w1 = wnv[j][1];
                u32x4 p; p.x = pk_bf16(v[j][0].x * rs2 * w0.x, v[j][0].y * rs2 * w0.y); p.y = pk_bf16(v[j][0].z * rs2 * w0.z, v[j][0].w * rs2 * w0.w);
                p.z = pk_bf16(v[j][1].x * rs2 * w1.x, v[j][1].y * rs2 * w1.y); p.w = pk_bf16(v[j][1].z * rs2 * w1.z, v[j][1].w * rs2 * w1.w);
                *(u32x4*)(P_XN + (size_t)m * DM + c8) = p; }
        }
#pragma unroll
        for (int j = 0; j < 4; ++j) { mv[j] = nmv[j]; xv[j][0] = nxv[j][0]; xv[j][1] = nxv[j][1]; }
        m = mn;
    }
}

typedef short v4i16_t __attribute__((ext_vector_type(4)));
__device__ __forceinline__ s16x4 vtr(const LAS unsigned char* p) { return __builtin_bit_cast(s16x4, __builtin_amdgcn_ds_read_tr16_b64_v4i16((LAS v4i16_t*)p)); }
__device__ __forceinline__ bf16x8 vtr8(const LAS unsigned char* lo, const LAS unsigned char* hi) { const s16x4 a = vtr(lo), b = vtr(hi); return __builtin_shufflevector(a, b, 0, 1, 2, 3, 4, 5, 6, 7); }

constexpr int AT_KPB = 144, AT_VPB = 192;
constexpr int AT_V_OFF = 256 * AT_KPB;
__device__ __forceinline__ void attn_load(Frame& F, int unit, u32x4 (&kv)[4], u32x4 (&vv)[4]) {
    const int b = unit >> 7, nb = (unit >> 2) & 31, kvh = unit & 3;
    const int tokc = b * SEQ + nb * 128;
#pragma unroll
    for (int i = 0; i < 4; ++i) {
        const int p = F.tid + NTHREADS * i, row = p >> 3, ch = p & 7;
        const bool valid = (nb > 0) || (row >= 128);
        kv[i] = (u32x4){0u, 0u, 0u, 0u}; vv[i] = (u32x4){0u, 0u, 0u, 0u};
        if (valid) { const bf16_t* src = P_PROJ + (size_t)(tokc - 128 + row) * DIN + 64 * kvh + 8 * ch; kv[i] = *(const u32x4*)(src + C_KA); vv[i] = *(const u32x4*)(src + C_VA); }
    }
}
__device__ __forceinline__ void attn_qload(Frame& F, int unit, int pp, int lane, bf16x8 (&Q)[4]) {
    const int b = unit >> 7, nb = (unit >> 2) & 31, kvh = unit & 3, pass = F.wave + 8 * pp, g = pass >> 2, c = pass & 3, hq = 4 * kvh + g;
    const bf16_t* qp = P_PROJ + (size_t)(b * SEQ + nb * 128 + 32 * c + (lane & 31)) * DIN + C_QA + 64 * hq + 8 * (lane >> 5);
#pragma unroll
    for (int ks = 0; ks < 4; ++ks) Q[ks] = *(const bf16x8*)(qp + 16 * ks);
}
__device__ __forceinline__ void attn_units(Frame& F, int l, int first, int stride) {
    LAS unsigned char* Ks = F.lds; LAS unsigned char* Vs = F.lds + AT_V_OFF;
    u32x4 kv[4], vv[4]; bf16x8 Qn[4];
    if (first < 512) { attn_load(F, first, kv, vv); attn_qload(F, first, 0, F.lane, Qn); }
#pragma unroll 1
  for (int unit = first; unit < 512; unit += stride) {
    int lane_ = F.lane; asm volatile("" : "+v"(lane_));
    const int lane = lane_, r32 = lane & 31, h2 = lane >> 5, tid = F.wave * 64 + lane;
    const int trq = (lane & 15) >> 2, trc = 16 * ((lane >> 4) & 1) + 4 * (lane & 3);
    const int b = unit >> 7, nb = (unit >> 2) & 31, kvh = unit & 3;
    const int tokc = b * SEQ + nb * 128;
    __syncthreads();
#pragma unroll
    for (int i = 0; i < 4; ++i) {
        const int p = tid + NTHREADS * i, row = p >> 3, ch = p & 7;
        *(LAS u32x4*)(Ks + row * AT_KPB + 16 * ch) = kv[i];
        *(LAS u32x4*)(Vs + row * AT_VPB + 16 * ch) = vv[i];
    }
    __syncthreads();
#pragma unroll 1
    for (int pp = 0; pp < 2; ++pp) {
        const int pass = F.wave + 8 * pp, g = pass >> 2, c = pass & 3, hq = 4 * kvh + g;
        const int qrow = tokc + 32 * c + r32;
        bf16x8 Qf[4];
#pragma unroll
        for (int ks = 0; ks < 4; ++ks) Qf[ks] = Qn[ks];
        if (pp == 0) { attn_qload(F, unit, 1, lane, Qn); if (unit + stride < 512) attn_load(F, unit + stride, kv, vv); }
        else if (unit + stride < 512) attn_qload(F, unit + stride, 0, lane, Qn);
        f32x16 s[5];
#pragma unroll
        for (int t = 0; t < 5; ++t) {
#pragma unroll
            for (int r = 0; r < 16; ++r) s[t][r] = 0.f;
#pragma unroll
            for (int ks = 0; ks < 4; ++ks) { const bf16x8 kf = *(const LAS bf16x8*)(Ks + (32 * (c + t) + r32) * AT_KPB + (16 * ks + 8 * h2) * 2); s[t] = MFMA32(kf, Qf[ks], s[t]); }
            __builtin_amdgcn_sched_barrier(0);
        }
        const float sink = ((const float*)(GAS const float*)F.ka->sinks)[l * 16 + hq];
        float mx = sink;
#pragma unroll
        for (int t = 0; t < 5; ++t) {
            const bool tile_ok = (nb > 0) || (c + t >= 4);
#pragma unroll
            for (int r = 0; r < 16; ++r) {
                float v = s[t][r];
                if (t == 0) v = (crow(r, h2) > r32) ? v : -1e30f;
                if (t == 4) v = (crow(r, h2) <= r32) ? v : -1e30f;
                v = tile_ok ? v : -1e30f;
                s[t][r] = v; mx = fmaxf(mx, v);
            }
        }
        mx = fmaxf(mx, __shfl_xor(mx, 32));
        float sum = 0.f;
#pragma unroll
        for (int t = 0; t < 5; ++t)
#pragma unroll
            for (int r = 0; r < 16; ++r) { const float p = __expf(s[t][r] - mx); s[t][r] = p; sum += p; }
        sum += __shfl_xor(sum, 32);
        __builtin_amdgcn_sched_barrier(0);
        const float inv = 1.0f / (sum + __expf(sink - mx));
        f32x16 o[2];
#pragma unroll
        for (int db = 0; db < 2; ++db)
#pragma unroll
            for (int r = 0; r < 16; ++r) o[db][r] = 0.f;
#pragma unroll
        for (int t = 0; t < 5; ++t) {
#pragma unroll
            for (int r = 0; r < 16; ++r) s[t][r] *= inv;
#pragma unroll
            for (int sk = 0; sk < 2; ++sk) {
                const bf16x8 pb = pack8(s[t], sk);
#pragma unroll
                for (int db = 0; db < 2; ++db) {
                    const LAS unsigned char* vp = Vs + (32 * (c + t) + 16 * sk + 4 * h2 + trq) * AT_VPB + (32 * db + trc) * 2;
                    const bf16x8 va = vtr8(vp, vp + 8 * AT_VPB);
                    o[db] = MFMA32(va, pb, o[db]);
                }
            }
            __builtin_amdgcn_sched_barrier(0);
        }
#pragma unroll
        for (int db = 0; db < 2; ++db)
#pragma unroll
            for (int rq = 0; rq < 4; ++rq) { const int d0 = 32 * db + 8 * rq + 4 * h2;
                u32x2 w; w.x = pk_bf16(o[db][4 * rq], o[db][4 * rq + 1]); w.y = pk_bf16(o[db][4 * rq + 2], o[db][4 * rq + 3]);
                *(u32x2*)(P_YARAW + (size_t)qrow * 1024 + 64 * hq + d0) = w; }
    }
  }
}

constexpr int RS_KPB = 576, RS_VPB = 64;
constexpr int RS_V_OFF = 128 * RS_KPB;
__device__ __forceinline__ void ret_scan_task(Frame& F, int task) {
    const int b = task >> 5, h = (task >> 3) & 3, e = task & 7;
    LAS unsigned char* Kt = F.lds; LAS unsigned char* Vs = F.lds + RS_V_OFF;
    const int lane = F.lane, r32 = lane & 31, h2 = lane >> 5, w = F.wave;
    const int trq = (lane & 15) >> 2, trc = 16 * ((lane >> 4) & 1) + 4 * (lane & 3);
    const float lg2 = __log2f(1.0f - exp2f(-5.0f - (float)h));
    const float g128 = exp2f(128.0f * lg2);
    f32x16 st;
#pragma unroll
    for (int r = 0; r < 16; ++r) st[r] = 0.f;
    u32x4 kA[8], vA, kB[8], vB;
    const bf16_t* kbase = P_PROJ + (size_t)(b * SEQ) * DIN + C_KR + 256 * h;
    const bf16_t* vbase = P_PROJ + (size_t)(b * SEQ) * DIN + C_VR + 256 * h + 32 * e;
#define RS_LOAD(KR, VR, cc) do { const size_t adv_ = (size_t)(128 * (cc)) * DIN; \
        _Pragma("unroll") for (int i = 0; i < 8; ++i) { const int p = tid_ + NTHREADS * i; KR[i] = *(const u32x4*)(kbase + adv_ + (size_t)(p >> 5) * DIN + 8 * (p & 31)); } \
        VR = *(const u32x4*)(vbase + adv_ + (size_t)(tid_ >> 2) * DIN + 8 * (tid_ & 3)); } while (0)
#define RS_STEP(KR, VR, cc) do { \
        __syncthreads(); \
        _Pragma("unroll") for (int i = 0; i < 8; ++i) { const int p = tid_ + NTHREADS * i; *(LAS u32x4*)(Kt + (p >> 5) * RS_KPB + 16 * (p & 31)) = KR[i]; } \
        *(LAS u32x4*)(Vs + (tid_ >> 2) * RS_VPB + 16 * (tid_ & 3)) = VR; \
        { bf16_t* sp = P_STATE + ((size_t)((b * 4 + h) * 32 + (cc))) * 65536 + 32 * w + r32_; \
          _Pragma("unroll") for (int r = 0; r < 16; ++r) sp[(size_t)(32 * e + crow(r, h2_)) * 256] = (bf16_t)(pk_bf16(st[r], 0.f) & 0xffffu); } \
        __syncthreads(); \
        if ((cc) + 2 < 32) RS_LOAD(KR, VR, (cc) + 2); \
        _Pragma("unroll") for (int ks = 0; ks < 8; ++ks) { \
            const LAS unsigned char* ap = Vs + (16 * ks + 8 * h2_ + trq_) * RS_VPB + trc_ * 2; \
            const LAS unsigned char* bp = Kt + (16 * ks + 8 * h2_ + trq_) * RS_KPB + (32 * w + trc_) * 2; \
            const bf16x8 af = vtr8(ap, ap + 4 * RS_VPB); const bf16x8 bfr = vtr8(bp, bp + 4 * RS_KPB); \
            st = MFMA32(af, bfr, st); } \
        _Pragma("unroll") for (int r = 0; r < 16; ++r) st[r] *= g128; } while (0)
    { const int tid_ = F.tid; RS_LOAD(kA, vA, 0); RS_LOAD(kB, vB, 1); }
#pragma unroll 1
    for (int c = 0; c < 32; c += 2) {
        int tid_ = F.tid; asm volatile("" : "+v"(tid_));
        const int l_ = tid_ & 63, r32_ = l_ & 31, h2_ = l_ >> 5, trq_ = (l_ & 15) >> 2, trc_ = 16 * ((l_ >> 4) & 1) + 4 * (l_ & 3);
        RS_STEP(kA, vA, c); RS_STEP(kB, vB, c + 1);
    }
#undef RS_LOAD
#undef RS_STEP
}

constexpr int RO_KPB = 528, RO_VPB = 576;
constexpr int RO_V_OFF = 128 * RO_KPB;
constexpr int RO_RED_OFF = RO_V_OFF + 128 * RO_VPB;
__device__ __forceinline__ void ret_out_task(Frame& F, int l, int task) {
    const int b = task >> 7, h = (task >> 5) & 3, c = task & 31;
    const int tok0 = b * SEQ + 128 * c;
    LAS unsigned char* Kc = F.lds; LAS unsigned char* Vs = F.lds + RO_V_OFF; LAS float* red = (LAS float*)(F.lds + RO_RED_OFF);
    int lane_ = F.lane; asm volatile("" : "+v"(lane_));
    const int lane = lane_, r32 = lane & 31, h2 = lane >> 5, w = F.wave, ib = w & 3, hv = w >> 2;
    const int trq = (lane & 15) >> 2, trc = 16 * ((lane >> 4) & 1) + 4 * (lane & 3);
    __syncthreads();
    {
        const unsigned char* sg = (const unsigned char*)(P_STATE + ((size_t)((b * 4 + h) * 32 + c)) * 65536);
#pragma unroll 1
        for (int i = 0; i < 16; ++i) {
            const int k = w + 8 * i, row = 2 * k + (lane >> 5), ch = (lane & 31) ^ (row & 31);
            __builtin_amdgcn_global_load_lds((const unsigned*)(sg + (size_t)row * 512 + ch * 16), (LAS unsigned*)(F.lds + k * 1024), 16, 0, 0);
        }
    }
    const bf16_t* qrow = P_PROJ + (size_t)(tok0 + 32 * ib + r32) * DIN + C_QR + 256 * h + 8 * h2;
    bf16x8 Qf[16];
#pragma unroll
    for (int ks = 0; ks < 16; ++ks) Qf[ks] = *(const bf16x8*)(qrow + 16 * ks);
    asm volatile("s_waitcnt vmcnt(0)" ::: "memory");
    __syncthreads();
    __builtin_amdgcn_sched_barrier(0);
    u32x4 kreg[8], vreg[8];
#pragma unroll
    for (int i = 0; i < 8; ++i) { const int p = (w * 64 + lane) + NTHREADS * i, row = p >> 5, ch = p & 31;
        const bf16_t* src = P_PROJ + (size_t)(tok0 + row) * DIN + 256 * h + 8 * ch;
        kreg[i] = *(const u32x4*)(src + C_KR); vreg[i] = *(const u32x4*)(src + C_VR); }
    __builtin_amdgcn_sched_barrier(0);
    f32x16 o[4];
#pragma unroll
    for (int t = 0; t < 4; ++t)
#pragma unroll
        for (int r = 0; r < 16; ++r) o[t][r] = 0.f;
#pragma unroll
    for (int ks = 0; ks < 16; ++ks) {
#pragma unroll
        for (int t = 0; t < 4; ++t) { const bf16x8 sa = *(const LAS bf16x8*)(F.lds + (128 * hv + 32 * t + r32) * 512 + (((2 * ks + h2) ^ r32) * 16)); o[t] = MFMA32(sa, Qf[ks], o[t]); }
        __builtin_amdgcn_sched_barrier(0);
    }
    __builtin_amdgcn_sched_barrier(0);
    __syncthreads();
#pragma unroll
    for (int i = 0; i < 8; ++i) { const int p = (w * 64 + lane) + NTHREADS * i, row = p >> 5, ch = p & 31;
        *(LAS u32x4*)(Kc + row * RO_KPB + 16 * ch) = kreg[i];
        *(LAS u32x4*)(Vs + row * RO_VPB + 16 * ch) = vreg[i]; }
    __syncthreads();
    __builtin_amdgcn_sched_barrier(0);
#pragma unroll
    for (int jb = 0; jb < 4; ++jb) if (jb <= ib) {
        f32x16 sA, sB;
#pragma unroll
        for (int r = 0; r < 16; ++r) { sA[r] = 0.f; sB[r] = 0.f; }
#pragma unroll
        for (int ks = 0; ks < 16; ks += 2) {
            const bf16x8 k0 = *(const LAS bf16x8*)(Kc + (32 * jb + r32) * RO_KPB + (16 * ks + 8 * h2) * 2);
            const bf16x8 k1 = *(const LAS bf16x8*)(Kc + (32 * jb + r32) * RO_KPB + (16 * (ks + 1) + 8 * h2) * 2);
            sA = MFMA32(k0, Qf[ks], sA); sB = MFMA32(k1, Qf[ks + 1], sB);
            __builtin_amdgcn_sched_barrier(0);
        }
#pragma unroll
        for (int r = 0; r < 16; ++r) { sA[r] += sB[r]; if (jb == ib && crow(r, h2) > r32) sA[r] = 0.f; }
#pragma unroll
        for (int sk = 0; sk < 2; ++sk) {
            const bf16x8 pb = pack8(sA, sk);
#pragma unroll
            for (int t = 0; t < 4; ++t) {
                const LAS unsigned char* vp = Vs + (32 * jb + 16 * sk + 4 * h2 + trq) * RO_VPB + (128 * hv + 32 * t + trc) * 2;
                const bf16x8 va = vtr8(vp, vp + 8 * RO_VPB);
                o[t] = MFMA32(va, pb, o[t]);
            }
        }
        __builtin_amdgcn_sched_barrier(0);
    }
    float ss = 0.f;
#pragma unroll
    for (int t = 0; t < 4; ++t)
#pragma unroll
        for (int r = 0; r < 16; ++r) ss += o[t][r] * o[t][r];
    ss += __shfl_xor(ss, 32);
    if (lane < 32) red[w * 32 + lane] = ss;
    __syncthreads();
    const float tot = red[w * 32 + r32] + red[(w ^ 4) * 32 + r32];
    const float rs = rsqrtf(tot * (1.0f / 256.0f) + EPS);
    const int tok = tok0 + 32 * ib + r32;
#pragma unroll
    for (int t = 0; t < 4; ++t)
#pragma unroll
        for (int rq = 0; rq < 4; ++rq) {
            const int dv0 = 128 * hv + 32 * t + 8 * rq + 4 * h2;
            const u32x2 gt = *(const u32x2*)(P_PROJ + (size_t)tok * DIN + C_GR + 256 * h + dv0);
            const f32x4 wn = *(const f32x4*)(((const float*)(GAS const float*)F.ka->ret_norm) + (size_t)l * 1024 + 256 * h + dv0);
            const float y0 = o[t][4 * rq] * rs * wn[0] * bf_lo(gt.x), y1 = o[t][4 * rq + 1] * rs * wn[1] * bf_hi(gt.x);
            const float y2 = o[t][4 * rq + 2] * rs * wn[2] * bf_lo(gt.y), y3 = o[t][4 * rq + 3] * rs * wn[3] * bf_hi(gt.y);
            u32x2 wv; wv.x = pk_bf16(y0, y1); wv.y = pk_bf16(y2, y3);
            *(u32x2*)(P_MIXIN + (size_t)tok * DM + 1024 + 256 * h + dv0) = wv;
        }
}

__device__ __forceinline__ void attn_norm_rows(Frame& F, int l) {
    const int gw = F.bid * NWAVES + F.wave, NGW = F.G * NWAVES;
    const f32x4* wn = (const f32x4*)(((const float*)(GAS const float*)F.ka->attn_norm) + (size_t)l * 1024);
    f32x4 wv[2][2];
#pragma unroll
    for (int j = 0; j < 2; ++j) { const int col = 8 * (F.lane + 64 * j); wv[j][0] = wn[col / 4]; wv[j][1] = wn[col / 4 + 1]; }
    for (int m0 = gw; m0 < M; m0 += 4 * NGW) {
        u32x4 v[4][2];
#pragma unroll
        for (int i = 0; i < 4; ++i) { const int m = m0 + i * NGW; if (m < M) { const u32x4* src = (const u32x4*)(P_YARAW + (size_t)m * 1024) + F.lane; v[i][0] = src[0]; v[i][1] = src[64]; } else { v[i][0] = (u32x4){0u, 0u, 0u, 0u}; v[i][1] = v[i][0]; } }
#pragma unroll
        for (int i = 0; i < 4; ++i) {
            const int m = m0 + i * NGW;
            float f[16]; float ss = 0.f;
#pragma unroll
            for (int j = 0; j < 2; ++j)
#pragma unroll
                for (int q = 0; q < 4; ++q) { f[8 * j + 2 * q] = bf_lo(v[i][j][q]); f[8 * j + 2 * q + 1] = bf_hi(v[i][j][q]); }
#pragma unroll
            for (int q = 0; q < 16; ++q) ss += f[q] * f[q];
            const float rs = rsqrtf(wave_sum(ss) * (1.0f / 1024.0f) + EPS);
            if (m < M) {
#pragma unroll
                for (int j = 0; j < 2; ++j) { const int col = 8 * (F.lane + 64 * j); const f32x4 w0 = wv[j][0], w1 = wv[j][1];
                    u32x4 o; o.x = pk_bf16(f[8 * j] * rs * w0[0], f[8 * j + 1] * rs * w0[1]); o.y = pk_bf16(f[8 * j + 2] * rs * w0[2], f[8 * j + 3] * rs * w0[3]);
                    o.z = pk_bf16(f[8 * j + 4] * rs * w1[0], f[8 * j + 5] * rs * w1[1]); o.w = pk_bf16(f[8 * j + 6] * rs * w1[2], f[8 * j + 7] * rs * w1[3]);
                    *(u32x4*)(P_MIXIN + (size_t)m * DM + col) = o; }
            }
        }
    }
}

__device__ __forceinline__ void conv_fixup(Frame& F, int l) {
    const float* cw = ((const float*)(GAS const float*)F.ka->conv_w) + (size_t)l * 3 * NUP; const float* cb = ((const float*)(GAS const float*)F.ka->conv_b) + (size_t)l * NUP;
    const int gt = F.bid * NTHREADS + F.tid, NGT = F.G * NTHREADS;
    constexpr int CG = DFF / 4;
    for (int idx = gt; idx < 128 * 2 * CG; idx += NGT) {
        const int cg4 = idx % CG, r = (idx / CG) & 1, hi = idx / (2 * CG);
        const int ca = 4 * cg4; const bool hasprev = (hi & 31) != 0;
        const f32x4 z = {0.f, 0.f, 0.f, 0.f};
        const float* e0 = P_EDGE + (size_t)(hi * 4) * NUP; const float* ep = P_EDGE + (size_t)((hi - 1) * 4) * NUP;
        f32x4 a0, a1, a2, g0, g1, g2;
        if (r == 0) {
            a2 = *(const f32x4*)(e0 + ca); g2 = *(const f32x4*)(e0 + DFF + ca);
            a1 = hasprev ? *(const f32x4*)(ep + 3 * NUP + ca) : z; g1 = hasprev ? *(const f32x4*)(ep + 3 * NUP + DFF + ca) : z;
            a0 = hasprev ? *(const f32x4*)(ep + 2 * NUP + ca) : z; g0 = hasprev ? *(const f32x4*)(ep + 2 * NUP + DFF + ca) : z;
        } else {
            a2 = *(const f32x4*)(e0 + NUP + ca); g2 = *(const f32x4*)(e0 + NUP + DFF + ca);
            a1 = *(const f32x4*)(e0 + ca); g1 = *(const f32x4*)(e0 + DFF + ca);
            a0 = hasprev ? *(const f32x4*)(ep + 3 * NUP + ca) : z; g0 = hasprev ? *(const f32x4*)(ep + 3 * NUP + DFF + ca) : z;
        }
        const f32x4 ua = *(const f32x4*)(cw + ca) * a0 + *(const f32x4*)(cw + NUP + ca) * a1 + *(const f32x4*)(cw + 2 * NUP + ca) * a2 + *(const f32x4*)(cb + ca);
        const f32x4 ug = *(const f32x4*)(cw + DFF + ca) * g0 + *(const f32x4*)(cw + NUP + DFF + ca) * g1 + *(const f32x4*)(cw + 2 * NUP + DFF + ca) * g2 + *(const f32x4*)(cb + DFF + ca);
        u32x2 w; w.x = pk_bf16(gelu_tanh(ua[0]) * ug[0], gelu_tanh(ua[1]) * ug[1]); w.y = pk_bf16(gelu_tanh(ua[2]) * ug[2], gelu_tanh(ua[3]) * ug[3]);
        *(u32x2*)(P_ACT + (size_t)(128 * hi + r) * DFF + ca) = w;
    }
}


#define XB_TMO      128
#define XB_XCNT(j)  (256  + 64 * (j))
#define XB_XSUB(j)  (1280 + 64 * (j))
#define XB_XGEN(j)  (2304 + 64 * (j))
#define XB_TOP      3328
#define XB_TOPGEN   3392
#define XCD_BAR_WORDS 3456
#define XB_SPIN_CAP (1u << 18)
__device__ __forceinline__ unsigned xb_ld(unsigned* p)              { return __hip_atomic_load(p, __ATOMIC_RELAXED, __HIP_MEMORY_SCOPE_AGENT); }
__device__ __forceinline__ unsigned xb_add(unsigned* p, unsigned v) { return __hip_atomic_fetch_add(p, v, __ATOMIC_RELAXED, __HIP_MEMORY_SCOPE_AGENT); }
__device__ __forceinline__ unsigned xb_xcc_id() { return (unsigned)__builtin_amdgcn_s_getreg((3 << 11) | 20) & 0xFu; }
#define XB_SPIN(cond, bar) do { unsigned _sp = 0; while (cond) { __builtin_amdgcn_s_sleep(1); \
    if ((++_sp & 255u) == 0u) { if (xb_ld(&(bar)[XB_TMO])) break; if (_sp > XB_SPIN_CAP) { atomicAdd(&(bar)[XB_TMO], 1u); break; } } } } while (0)
struct XcdBarrier { unsigned* bar; unsigned x; volatile LAS unsigned* st; };
__device__ __forceinline__ XcdBarrier xcd_barrier_post(unsigned* bar, volatile LAS unsigned* st) {
    XcdBarrier b; b.bar = bar; b.x = xb_xcc_id(); b.st = st;
    if (threadIdx.x == 0) (void)xb_add(&bar[XB_XCNT(b.x)], 1u);
    return b;
}
__device__ __forceinline__ void xcd_barrier_complete(unsigned* bar, unsigned x, unsigned& nloc, unsigned& nx) {
    const unsigned G = gridDim.x * gridDim.y * gridDim.z;
    unsigned sum, cnt, mine, sp = 0u;
    for (;;) {
        sum = 0u; cnt = 0u; mine = 0u;
#pragma unroll
        for (unsigned j = 0; j < 16; ++j) { const unsigned c = xb_ld(&bar[XB_XCNT(j)]); sum += c; cnt += (c > 0u) ? 1u : 0u; mine = (j == x) ? c : mine; }
        if (sum == G) break;
        __builtin_amdgcn_s_sleep(1);
        if ((++sp & 255u) == 0u) { if (xb_ld(&bar[XB_TMO])) break; if (sp > XB_SPIN_CAP) { atomicAdd(&bar[XB_TMO], 1u); break; } }
    }
    nloc = mine > 0u ? mine : 1u; nx = cnt > 0u ? cnt : 1u;
}
__device__ __forceinline__ void xcd_barrier(const XcdBarrier& b) {
    asm volatile("s_waitcnt vmcnt(0)" ::: "memory");
    __syncthreads();
    if (threadIdx.x == 0) {
        unsigned* bar = b.bar;
        __builtin_amdgcn_s_waitcnt(0);
        unsigned nloc = b.st[0], nx = b.st[1];
        if (nloc == 0u) { xcd_barrier_complete(bar, b.x, nloc, nx); b.st[0] = nloc; b.st[1] = nx; }
        const unsigned old = xb_add(&bar[XB_XSUB(b.x)], 1u);
        const unsigned gen = old / nloc;
        if (old + 1u == (gen + 1u) * nloc) {
            __builtin_amdgcn_fence(__ATOMIC_RELEASE, "agent");
            asm volatile("s_waitcnt vmcnt(0)" ::: "memory");
            const unsigned og = xb_add(&bar[XB_TOP], 1u);
            const unsigned tg = og / nx;
            if (og + 1u == (tg + 1u) * nx) xb_add(&bar[XB_TOPGEN], 1u);
            else XB_SPIN(xb_ld(&bar[XB_TOPGEN]) == tg, bar);
            __builtin_amdgcn_fence(__ATOMIC_ACQUIRE, "agent");
            xb_add(&bar[XB_XGEN(b.x)], 1u);
            asm volatile("s_waitcnt vmcnt(0)" ::: "memory");
        } else {
            XB_SPIN(xb_ld(&bar[XB_XGEN(b.x)]) == gen, bar);
            __builtin_amdgcn_fence(__ATOMIC_ACQUIRE, "agent");
            asm volatile("s_waitcnt vmcnt(0)" ::: "memory");
        }
    }
    __syncthreads();
}
constexpr int LDS_BARW_OFF = LDS_BYTES - 64;

constexpr int NPHASES = 1 + DEPTH * 9;
__global__ void __launch_bounds__(NTHREADS, 2) fwd_kernel(Args args) {
    extern __shared__ __attribute__((aligned(16))) unsigned char lds_raw[];
    Frame F;
    F.lds = (LAS unsigned char*)lds_raw;
    F.tid = threadIdx.x; F.lane = F.tid & 63; F.wave = __builtin_amdgcn_readfirstlane(F.tid >> 6);
    F.G = gridDim.x; F.bid = blockIdx.x; F.ka = (KArgs)__builtin_amdgcn_kernarg_segment_ptr();
    F.ws = (GAS unsigned char*)F.ka->ws;

    if (threadIdx.x < 16) ((LAS unsigned*)(F.lds + LDS_BARW_OFF))[threadIdx.x] = 0u;
    __syncthreads();
    const XcdBarrier xbar = xcd_barrier_post((unsigned*)(GAS unsigned*)F.ka->ws, (volatile LAS unsigned*)(F.lds + LDS_BARW_OFF));
    const int ph_hi = F.ka->ph_hi;
    for (int ph = F.ka->ph_lo; ph < ph_hi; ++ph) {
        { int t_ = threadIdx.x; asm volatile("" : "+v"(t_)); F.tid = t_; F.lane = t_ & 63; F.wave = __builtin_amdgcn_readfirstlane(t_ >> 6);
          int b_ = blockIdx.x; asm volatile("" : "+s"(b_)); F.bid = b_; int g_ = gridDim.x; asm volatile("" : "+s"(g_)); F.G = g_;
          unsigned long long w_ = (unsigned long long)F.ka->ws; asm volatile("" : "+s"(w_)); F.ws = (GAS unsigned char*)w_;
          unsigned l_ = (unsigned)(size_t)lds_raw; asm volatile("" : "+s"(l_)); F.lds = (LAS unsigned char*)(size_t)l_; }
        if (ph == 0) {
            if (DBG_MASK & 1) p0_prologue(F);
        } else {
            const int l = (ph - 1) / 9, sp = (ph - 1) % 9;
            if (sp == 0 && (DBG_MASK & 2)) {
                pg8::Gemm g{P_XN, P_WinT + (size_t)l * DIN * DM, M, DIN, DM}; pg8::StaticOrder S; S.init(M, DIN, F.G, F.bid);
                pg8::EpiProj E{P_PROJ, P_ROPEA, P_ROPER};
                pg8::gemm_phase<pg8::EpiProj>(F.lds, g, S, E, F.tid);
            } else if (sp == 1 && (DBG_MASK & 4)) {
                if (F.G >= 256) {
                    if (F.bid < 128) ret_scan_task(F, F.bid);
                    else attn_units(F, l, F.bid - 128, F.G - 128);
                } else {
                    for (int t = F.bid; t < 128 + 512; t += F.G) { if (t < 128) ret_scan_task(F, t); else attn_units(F, l, t - 128, 512); }
                }
            } else if (sp == 2 && (DBG_MASK & 8)) {
                for (int t = F.bid; t < 512; t += F.G) ret_out_task(F, l, t);
                attn_norm_rows(F, l);
            } else if (sp == 3 && (DBG_MASK & 16)) {
                pg8::Gemm g{P_MIXIN, P_WoutT + (size_t)l * DM * DM, M, DM, DM}; pg8::StaticOrder S; S.init(M, DM, F.G, F.bid);
                pg8::EpiBf16 E{P_MIXB, DM};
                pg8::gemm_phase<pg8::EpiBf16>(F.lds, g, S, E, F.tid);
            } else if (sp == 4 && (DBG_MASK & 32)) {
                if (l == 0) rowpass<true, false>(F, ((const float*)(GAS const float*)F.ka->x), P_MIXB, ((const float*)(GAS const float*)F.ka->post_mix), ((const float*)(GAS const float*)F.ka->pre_ffn), P_XR, 2);
                else rowpass<false, false>(F, P_XR, P_MIXB, ((const float*)(GAS const float*)F.ka->post_mix) + (size_t)l * DM, ((const float*)(GAS const float*)F.ka->pre_ffn) + (size_t)l * DM, P_XR, 2);
            } else if (sp == 5 && (DBG_MASK & 64)) {
                pg8::Gemm g{P_XR, P_WupT + (size_t)l * NUP * DM, M, NUP, DM};   pg8::StaticOrder S; S.init(M, NUP, F.G, F.bid);
                pg8::EpiUpConv E{P_ACT, P_EDGE, ((const float*)(GAS const float*)F.ka->conv_w) + (size_t)l * 3 * NUP, ((const float*)(GAS const float*)F.ka->conv_b) + (size_t)l * NUP, P_RS};
                pg8::gemm_phase<pg8::EpiUpConv>(F.lds, g, S, E, F.tid);
            } else if (sp == 6 && (DBG_MASK & 128)) {
                conv_fixup(F, l);
            } else if (sp == 7 && (DBG_MASK & 256)) {
                pg8::Gemm g{P_ACT, P_WdnT + (size_t)l * DM * DFF, M, DM, DFF}; pg8::StaticOrder S; S.init(M, DM, F.G, F.bid);
                pg8::EpiBf16 E{P_MIX2B, DM};
                pg8::gemm_phase<pg8::EpiBf16>(F.lds, g, S, E, F.tid);
            } else if (sp == 8 && (DBG_MASK & 512)) {
                if (l + 1 < DEPTH) rowpass<false, false>(F, P_XR, P_MIX2B, ((const float*)(GAS const float*)F.ka->post_ffn) + (size_t)l * DM, ((const float*)(GAS const float*)F.ka->pre_mix) + (size_t)(l + 1) * DM, P_XR, 1);
                else rowpass<false, true>(F, P_XR, P_MIX2B, ((const float*)(GAS const float*)F.ka->post_ffn) + (size_t)l * DM, ((const float*)(GAS const float*)F.ka->pre_mix), ((float*)(GAS float*)F.ka->out), 0);
            }
        }
        if (ph + 1 < ph_hi) {
            if (ph_hi > NPHASES) { __syncthreads(); cg::this_grid().sync(); }
            else xcd_barrier(xbar);
        }
    }
}

extern "C" void kernel_launch(void* const* d_in, const int* in_sizes, int n_in, void* d_out, int out_size, void* d_ws, size_t ws_size, hipStream_t stream) {
    static int grid = 0;
    if (grid == 0) {
        if (n_in != 15 || in_sizes[0] != M * DM || out_size != M * DM || ws_size < WS_END) {
            fprintf(stderr, "kernel_launch: unexpected shapes (n_in %d, in0 %d, out %d, ws %zu < %zu)\n", n_in, n_in > 0 ? in_sizes[0] : -1, out_size, ws_size, (size_t)WS_END); grid = -1; return; }
        int dev = 0, cus = 0, per_cu = 0;
        hipGetDevice(&dev); hipDeviceGetAttribute(&cus, hipDeviceAttributeMultiprocessorCount, dev);
        hipFuncSetAttribute((const void*)fwd_kernel, hipFuncAttributeMaxDynamicSharedMemorySize, LDS_BYTES);
        hipOccupancyMaxActiveBlocksPerMultiprocessor(&per_cu, (const void*)fwd_kernel, NTHREADS, LDS_BYTES);
        if (per_cu < 1) per_cu = 1;
        (void)hipGetLastError();
        grid = cus * per_cu;
        if (grid > 256) grid = 256;
    }
    if (grid < 0) return;
    Args a{};
    a.x = (const float*)d_in[0]; a.pos = (const int*)d_in[1]; a.w_in = (const float*)d_in[2]; a.w_out = (const float*)d_in[3]; a.w_up = (const float*)d_in[4];
    a.w_down = (const float*)d_in[5]; a.conv_w = (const float*)d_in[6]; a.conv_b = (const float*)d_in[7]; a.sinks = (const float*)d_in[8];
    a.pre_mix = (const float*)d_in[9]; a.post_mix = (const float*)d_in[10]; a.attn_norm = (const float*)d_in[11]; a.ret_norm = (const float*)d_in[12];
    a.pre_ffn = (const float*)d_in[13]; a.post_ffn = (const float*)d_in[14];
    a.out = (float*)d_out; a.ws = (unsigned char*)d_ws;
#if MK_SINGLE
    hipMemsetAsync(d_ws, 0, 16384, stream);
    a.ph_lo = 0; a.ph_hi = NPHASES;
    void* kargs[] = {&a};
    hipError_t e = hipLaunchCooperativeKernel((const void*)fwd_kernel, dim3(grid), dim3(NTHREADS), kargs, LDS_BYTES, stream);
    if (e != hipSuccess) fprintf(stderr, "cooperative launch failed: %s (grid %d)\n", hipGetErrorString(e), grid);
#else
    for (int ph = 0; ph < NPHASES; ++ph) { a.ph_lo = ph; a.ph_hi = ph + 1; hipLaunchKernelGGL(fwd_kernel, dim3(grid), dim3(NTHREADS), LDS_BYTES, stream, a); }
#endif
}
```

```cpp
#include <hip/hip_runtime.h>
#include <hip/hip_cooperative_groups.h>
#include <cstdio>
namespace cg = cooperative_groups;

#ifndef MK_SINGLE
#define MK_SINGLE 1
#endif

#ifndef DBG_MASK
#define DBG_MASK 1023
#endif
#define LAS __attribute__((address_space(3)))
#define GAS __attribute__((address_space(1)))
typedef unsigned short bf16_t;
typedef short bf16x8 __attribute__((ext_vector_type(8)));
typedef short s16x4 __attribute__((ext_vector_type(4)));
typedef float f32x4 __attribute__((ext_vector_type(4)));
typedef float f32x16 __attribute__((ext_vector_type(16)));
typedef unsigned u32x4 __attribute__((ext_vector_type(4)));
typedef unsigned u32x2 __attribute__((ext_vector_type(2)));

constexpr int BATCH = 4, SEQ = 4096, DM = 2048, M = BATCH * SEQ, DIN = 5632, DFF = 5632, NUP = 11264, DEPTH = 2;
constexpr int C_QA = 0, C_KA = 1024, C_VA = 1280, C_QR = 1536, C_KR = 2560, C_VR = 3584, C_GR = 4608;
constexpr float EPS = 1e-6f;
constexpr int NTHREADS = 512, NWAVES = 8;
constexpr int LDS_BYTES = 147456;

constexpr size_t MiB = 1u << 20;
constexpr size_t SZ_WIN = (size_t)DIN * DM * 2, SZ_WOUT = (size_t)DM * DM * 2, SZ_WUP = (size_t)NUP * DM * 2, SZ_WDN = (size_t)DM * DFF * 2;
constexpr size_t WS_WIN = 1 * MiB;
constexpr size_t WS_WOUT = WS_WIN + 2 * SZ_WIN;
constexpr size_t WS_WUP = WS_WOUT + 2 * SZ_WOUT;
constexpr size_t WS_WDN = WS_WUP + 2 * SZ_WUP;
constexpr size_t WS_XN = WS_WDN + 2 * SZ_WDN;
constexpr size_t WS_BIG = WS_XN + (size_t)M * DM * 2;
constexpr size_t WS_MIXIN = WS_BIG + (size_t)M * DIN * 2;
constexpr size_t WS_YARAW = WS_MIXIN + (size_t)M * DM * 2;
constexpr size_t WS_STATE = WS_YARAW + (size_t)M * 1024 * 2;
constexpr size_t WS_ROPEA = WS_STATE + (size_t)BATCH * 4 * 32 * 65536 * 2;
constexpr size_t WS_ROPER = WS_ROPEA + (size_t)M * 16 * 4;
constexpr size_t WS_EDGE = WS_ROPER + (size_t)M * 256 * 4;
constexpr size_t WS_XR = WS_EDGE + (size_t)128 * 4 * NUP * 4;
constexpr size_t WS_END = WS_XR + (size_t)M * DM * 2;
static_assert((size_t)M * DM * 4 <= (size_t)M * DM * 2 + (size_t)M * 1024 * 2 + (size_t)BATCH * 4 * 32 * 65536 * 2, "MIX2 overlay");

__device__ __forceinline__ unsigned pk_bf16(float lo, float hi) {
    typedef float f32x2_t __attribute__((ext_vector_type(2)));
    typedef __bf16 bf16x2_t __attribute__((ext_vector_type(2)));
    f32x2_t v = {lo, hi}; bf16x2_t b = __builtin_convertvector(v, bf16x2_t);
    return __builtin_bit_cast(unsigned, b);
}
__device__ __forceinline__ float bf_lo(unsigned u) { return __uint_as_float(u << 16); }
__device__ __forceinline__ float bf_hi(unsigned u) { return __uint_as_float(u & 0xffff0000u); }
__device__ __forceinline__ float wave_sum(float v) {
#pragma unroll
    for (int o = 1; o < 64; o <<= 1) v += __shfl_xor(v, o);
    return v;
}
__device__ __forceinline__ int crow(int r, int h) { return (r & 3) + 8 * (r >> 2) + 4 * h; }
__device__ __forceinline__ bf16x8 pack8(const f32x16& x, int s) {
    u32x4 p;
    p[0] = pk_bf16(x[8 * s + 0], x[8 * s + 1]); p[1] = pk_bf16(x[8 * s + 2], x[8 * s + 3]);
    p[2] = pk_bf16(x[8 * s + 4], x[8 * s + 5]); p[3] = pk_bf16(x[8 * s + 6], x[8 * s + 7]);
    return __builtin_bit_cast(bf16x8, p);
}
#define MFMA32(a, b, c) __builtin_amdgcn_mfma_f32_32x32x16_bf16((a), (b), (c), 0, 0, 0)
__device__ __forceinline__ float gelu_tanh(float a) {
    const float u = a * (2.3022082f + 0.10294324f * a * a);
    return a * __builtin_amdgcn_rcpf(1.0f + __builtin_amdgcn_exp2f(-u));
}
__device__ __forceinline__ float silu_f(float x) { return x * __builtin_amdgcn_rcpf(1.0f + __builtin_amdgcn_exp2f(-1.4426950409f * x)); }

struct Args {
    const float* x; const int* pos; const float* w_in; const float* w_out; const float* w_up; const float* w_down;
    const float* conv_w; const float* conv_b; const float* sinks; const float* pre_mix; const float* post_mix;
    const float* attn_norm; const float* ret_norm; const float* pre_ffn; const float* post_ffn;
    float* out; unsigned char* ws; int ph_lo, ph_hi;
};

template <int CTRL> __device__ __forceinline__ float dpp_ror(float v) { return __builtin_bit_cast(float, __builtin_amdgcn_update_dpp(0, __builtin_bit_cast(int, v), CTRL, 0xf, 0xf, false)); }

namespace pg8 {
constexpr int BM = 256, BK = 64, HALF = 128, HTB = HALF * BK * 2, STAGE_BYTES = 8 * HTB, NXCD = 8, WGM = 8;
__device__ __forceinline__ int lds_byte(int r, int c) { const int st = (r >> 4) * 2 + (c >> 5), rr = r & 15, cc = c & 31, ob = rr * 64 + cc * 2; return st * 1024 + (ob ^ (((ob >> 9) & 1) << 5)); }
__device__ __forceinline__ void stage_rc(int b, int& R, int& C) { const int st = b / 1024, sb = b % 1024, swz = sb ^ (((sb >> 9) & 1) << 5); R = (st >> 1) * 16 + swz / 64; C = (st & 1) * 32 + (swz % 64) / 2; }
__device__ __forceinline__ int perm32(int rho) { const int n = rho >> 4, i = rho & 15; return 8 * (i >> 2) + 4 * n + (i & 3); }
struct Unit { int pm, pn; };
struct Gemm { const bf16_t* A; const bf16_t* Bt; int M, N, K; };
struct StaticOrder {
    int nM, nN, nwg, G, c;
    __device__ void init(int M_, int N_, int G_, int c_) { nM = M_ / BM; nN = N_ / BM; nwg = nM * nN; G = G_; c = c_; }
    __device__ bool next(int i, Unit& u) const {
        const long L = (long)i * G + c; if (L >= nwg) return false;
        int wgid = (int)L; { const int q = nwg / NXCD, r = nwg % NXCD, xcd = wgid % NXCD, off = wgid / NXCD; wgid = (xcd < r ? xcd * (q + 1) : r * (q + 1) + (xcd - r) * q) + off; }
        const int nig = WGM * nN, gid = wgid / nig, fm = gid * WGM, gsz = (nM - fm) < WGM ? (nM - fm) : WGM;
        u.pm = fm + ((wgid % nig) % gsz); u.pn = (wgid % nig) / gsz; return true;
    }
};

#ifndef PG8_ALIGN
#define PG8_ALIGN true
#endif
#ifndef PG8_SP2
#define PG8_SP2 true
#endif
template <class Epi, bool ALIGN_EPI = PG8_ALIGN, bool SP2 = PG8_SP2>
__device__ __forceinline__ void gemm_phase(LAS unsigned char* lds, const Gemm g, const StaticOrder& S, const Epi& E, const int tid) {
    const int wid = __builtin_amdgcn_readfirstlane(tid >> 6), lane = tid & 63, wr = wid >> 2, wc = wid & 3, fr = lane & 15, fq = lane >> 4;
    const int K = g.K, nt = K / BK;
    unsigned voffA[2], voffB[2];
#pragma unroll
    for (int i = 0; i < 2; ++i) { int R, C; stage_rc(tid * 16 + i * 8192, R, C); const int Rb = Epi::PERM ? ((R & ~31) + perm32(R & 31)) : R;
        const int Ra = Epi::AROWPERM ? (128 * (R >> 6) + 8 * (R & 15) + ((R >> 4) & 3)) : R;
        voffA[i] = (unsigned)(Ra * K + C) * 2u; voffB[i] = (unsigned)(Rb * K + C) * 2u; }
    const size_t kstep = (size_t)(BK * 2);
    const size_t hstepB = (size_t)HALF * K * 2;
    const size_t hstepA = Epi::AROWPERM ? (size_t)4 * K * 2 : (size_t)HALF * K * 2;
    const size_t tstep = (size_t)BM * K * 2;
    const unsigned ldsw = (unsigned)wid * 1024u;
    const int aoff = lds_byte(wr * 64 + fr, fq * 8), boff = lds_byte(wc * 32 + fr, fq * 8);
#define PG8_SA(b, h) (((b) * 2 + (h)) * HTB)
#define PG8_SB(b, h) ((4 + (b) * 2 + (h)) * HTB)
#define PG8_STAGE(bufoff, gbase, voff) do { _Pragma("unroll") for (int _i = 0; _i < 2; ++_i) \
        __builtin_amdgcn_global_load_lds((const unsigned*)((const char*)(gbase) + (voff)[_i]), (LAS unsigned*)(lds + (bufoff) + ldsw + _i * 8192), 16, 0, 0); } while (0)
#define PG8_LDA(dst, b, h) do { _Pragma("unroll") for (int m = 0; m < 4; ++m) _Pragma("unroll") for (int k = 0; k < 2; ++k) dst[m][k] = *(const LAS bf16x8*)(lds + PG8_SA(b, h) + aoff + m * 2048 + k * 1024); } while (0)
#define PG8_LDB(dst, b, h) do { _Pragma("unroll") for (int n = 0; n < 2; ++n) _Pragma("unroll") for (int k = 0; k < 2; ++k) dst[n][k] = *(const LAS bf16x8*)(lds + PG8_SB(b, h) + boff + n * 2048 + k * 1024); } while (0)
#define PG8_MMA(ai, bj, At, Bt) do { __builtin_amdgcn_s_setprio(1); _Pragma("unroll") for (int m = 0; m < 4; ++m) _Pragma("unroll") for (int n = 0; n < 2; ++n) _Pragma("unroll") for (int k = 0; k < 2; ++k) \
        acc[ai][bj][m][n] = __builtin_amdgcn_mfma_f32_16x16x32_bf16(Bt[n][k], At[m][k], acc[ai][bj][m][n], 0, 0, 0); __builtin_amdgcn_s_setprio(0); } while (0)
#define PG8_WAIT_V(n) asm volatile("s_waitcnt vmcnt(" #n ")" ::: "memory")
#define PG8_WAIT_L(n) asm volatile("s_waitcnt lgkmcnt(" #n ")" ::: "memory")
#define PG8_BAR __builtin_amdgcn_s_barrier()
#define PG8_SCHED __builtin_amdgcn_sched_barrier(0)
    Unit cur, nxt; int ui = 0;
    if (!S.next(0, cur)) return;
    f32x4 acc[2][2][4][2];
#pragma unroll
    for (int a = 0; a < 2; ++a)
#pragma unroll
        for (int b = 0; b < 2; ++b)
#pragma unroll
            for (int m = 0; m < 4; ++m)
#pragma unroll
                for (int n = 0; n < 2; ++n) acc[a][b][m][n] = (f32x4){0.f, 0.f, 0.f, 0.f};
    bf16x8 At[4][2], B0[2][2], B1[2][2];
    const char* cA = (const char*)g.A + (size_t)cur.pm * tstep; const char* cB = (const char*)g.Bt + (size_t)cur.pn * tstep;
    typename Epi::Pre pre = E.prefetch(cur, wr, wc, lane);
    if constexpr (SP2) {
        PG8_STAGE(PG8_SB(0, 0), cB, voffB); PG8_STAGE(PG8_SB(0, 1), cB + hstepB, voffB); PG8_STAGE(PG8_SA(0, 0), cA, voffA); PG8_STAGE(PG8_SA(0, 1), cA + hstepA, voffA);
        if (wr == 1) PG8_BAR;
        PG8_WAIT_V(2); PG8_BAR;
        PG8_STAGE(PG8_SB(1, 0), cB + kstep, voffB); PG8_STAGE(PG8_SA(1, 0), cA + kstep, voffA); PG8_STAGE(PG8_SB(1, 1), cB + hstepB + kstep, voffB);
        PG8_WAIT_V(6); PG8_BAR;
    } else {
    PG8_STAGE(PG8_SB(0, 0), cB, voffB); PG8_STAGE(PG8_SA(0, 0), cA, voffA); PG8_STAGE(PG8_SB(0, 1), cB + hstepB, voffB); PG8_STAGE(PG8_SA(0, 1), cA + hstepA, voffA);
    if (wr == 1) PG8_BAR;
    PG8_WAIT_V(4); PG8_BAR;
    PG8_STAGE(PG8_SB(1, 0), cB + kstep, voffB); PG8_STAGE(PG8_SA(1, 0), cA + kstep, voffA); PG8_STAGE(PG8_SB(1, 1), cB + hstepB + kstep, voffB);
    PG8_WAIT_V(6); PG8_BAR;
    }
    for (;;) {
        const bool has_next = S.next(ui + 1, nxt);
        const char* nA = has_next ? (const char*)g.A + (size_t)nxt.pm * tstep : cA; const char* nB = has_next ? (const char*)g.Bt + (size_t)nxt.pn * tstep : cB;
        for (int t = 0; t < nt; t += 2) {
            const bool last = (t == nt - 2);
            const char* a1 = cA + (size_t)(t + 1) * kstep;
            const char* a2 = last ? nA : cA + (size_t)(t + 2) * kstep; const char* b2 = last ? nB : cB + (size_t)(t + 2) * kstep;
            const char* a3 = a2 + kstep; const char* b3 = b2 + kstep;
            if constexpr (SP2) {
            PG8_LDB(B0, 0, 0); PG8_LDB(B1, 0, 1); PG8_SCHED; PG8_LDA(At, 0, 0); PG8_STAGE(PG8_SA(1, 1), a1 + hstepA, voffA);
            PG8_WAIT_V(8); PG8_WAIT_L(0); PG8_BAR; PG8_MMA(0, 0, At, B0); PG8_MMA(0, 1, At, B1); PG8_BAR; PG8_SCHED;
            PG8_LDA(At, 0, 1); PG8_STAGE(PG8_SB(0, 0), b2, voffB); PG8_STAGE(PG8_SB(0, 1), b2 + hstepB, voffB); PG8_STAGE(PG8_SA(0, 0), a2, voffA);
            PG8_WAIT_V(8); PG8_WAIT_L(0); PG8_BAR; PG8_MMA(1, 0, At, B0); PG8_MMA(1, 1, At, B1); PG8_BAR; PG8_SCHED;
            PG8_LDB(B0, 1, 0); PG8_LDB(B1, 1, 1); PG8_SCHED; PG8_LDA(At, 1, 0); PG8_STAGE(PG8_SA(0, 1), a2 + hstepA, voffA);
            PG8_WAIT_V(8); PG8_WAIT_L(0); PG8_BAR; PG8_MMA(0, 0, At, B0); PG8_MMA(0, 1, At, B1); PG8_BAR; PG8_SCHED;
            PG8_LDA(At, 1, 1); PG8_STAGE(PG8_SB(1, 0), b3, voffB); PG8_STAGE(PG8_SB(1, 1), b3 + hstepB, voffB); PG8_STAGE(PG8_SA(1, 0), a3, voffA);
            PG8_WAIT_V(8); PG8_WAIT_L(0); PG8_BAR; PG8_MMA(1, 0, At, B0); PG8_MMA(1, 1, At, B1); PG8_BAR; PG8_SCHED;
            } else {
            PG8_LDB(B0, 0, 0); PG8_SCHED; PG8_LDA(At, 0, 0); PG8_STAGE(PG8_SA(1, 1), a1 + hstepA, voffA);
            PG8_WAIT_L(8); PG8_BAR; PG8_WAIT_L(0); PG8_MMA(0, 0, At, B0); PG8_BAR; PG8_SCHED;
            PG8_LDB(B1, 0, 1); PG8_STAGE(PG8_SB(0, 0), b2, voffB);
            PG8_BAR; PG8_WAIT_L(0); PG8_MMA(0, 1, At, B1); PG8_BAR;
            PG8_LDA(At, 0, 1); PG8_STAGE(PG8_SA(0, 0), a2, voffA);
            PG8_BAR; PG8_WAIT_L(0); PG8_MMA(1, 0, At, B0); PG8_BAR; PG8_SCHED;
            PG8_STAGE(PG8_SB(0, 1), b2 + hstepB, voffB);
            PG8_WAIT_V(6); PG8_BAR; PG8_MMA(1, 1, At, B1); PG8_BAR;
            PG8_LDB(B0, 1, 0); PG8_SCHED; PG8_LDA(At, 1, 0); PG8_STAGE(PG8_SA(0, 1), a2 + hstepA, voffA);
            PG8_WAIT_L(8); PG8_BAR; PG8_WAIT_L(0); PG8_MMA(0, 0, At, B0); PG8_BAR; PG8_SCHED;
            PG8_LDB(B1, 1, 1); PG8_STAGE(PG8_SB(1, 0), b3, voffB);
            PG8_BAR; PG8_WAIT_L(0); PG8_MMA(0, 1, At, B1); PG8_BAR;
            PG8_LDA(At, 1, 1); PG8_STAGE(PG8_SA(1, 0), a3, voffA);
            PG8_BAR; PG8_WAIT_L(0); PG8_MMA(1, 0, At, B0); PG8_BAR; PG8_SCHED;
            PG8_STAGE(PG8_SB(1, 1), b3 + hstepB, voffB);
            PG8_WAIT_V(6); PG8_BAR; PG8_MMA(1, 1, At, B1); PG8_BAR;
            }
        }
        if constexpr (ALIGN_EPI) { if (wr == 0) PG8_BAR; }
        E(acc, cur, wr, wc, fr, fq, pre, lds);
        if (!has_next) break;
        pre = E.prefetch(nxt, wr, wc, lane);
#pragma unroll
        for (int a = 0; a < 2; ++a)
#pragma unroll
            for (int b = 0; b < 2; ++b)
#pragma unroll
                for (int m = 0; m < 4; ++m)
#pragma unroll
                    for (int n = 0; n < 2; ++n) acc[a][b][m][n] = (f32x4){0.f, 0.f, 0.f, 0.f};
        cur = nxt; cA = nA; cB = nB; ++ui;
        if constexpr (ALIGN_EPI) { if (wr == 1) PG8_BAR; }
    }
    PG8_WAIT_V(0);
    if constexpr (!ALIGN_EPI) { if (wr == 0) PG8_BAR; }
    PG8_BAR;
#undef PG8_SA
#undef PG8_SB
#undef PG8_STAGE
#undef PG8_LDA
#undef PG8_LDB
#undef PG8_MMA
#undef PG8_WAIT_V
#undef PG8_WAIT_L
#undef PG8_BAR
#undef PG8_SCHED
}

struct EpiF32 {
    static constexpr bool PERM = false, AROWPERM = false;
    float* C; int ldc;
    struct Pre {};
    __device__ __forceinline__ Pre prefetch(const Unit&, int, int, int) const { return Pre{}; }
    __device__ __forceinline__ void operator()(const f32x4 (&acc)[2][2][4][2], const Unit& u, int wr, int wc, int fr, int fq, const Pre&, LAS unsigned char*) const {
        const int row0 = u.pm * BM + wr * 64 + fr, col0 = u.pn * BM + wc * 32 + 4 * fq;
#pragma unroll
        for (int ai = 0; ai < 2; ++ai)
#pragma unroll
            for (int m = 0; m < 4; ++m) { float* rowp = C + (size_t)(row0 + ai * HALF + m * 16) * ldc + col0;
#pragma unroll
                for (int bj = 0; bj < 2; ++bj)
#pragma unroll
                    for (int n = 0; n < 2; ++n) *(f32x4*)(rowp + bj * HALF + n * 16) = acc[ai][bj][m][n]; }
    }
};

struct EpiBf16 {
    static constexpr bool PERM = true, AROWPERM = false;
    bf16_t* O; int ldc;
    struct Pre {};
    __device__ __forceinline__ Pre prefetch(const Unit&, int, int, int) const { return Pre{}; }
    __device__ __forceinline__ void operator()(const f32x4 (&acc)[2][2][4][2], const Unit& u, int wr, int wc, int fr, int fq, const Pre&, LAS unsigned char*) const {
        const int row0 = u.pm * BM + wr * 64 + fr, col0 = u.pn * BM + wc * 32 + 8 * fq;
#pragma unroll
        for (int ai = 0; ai < 2; ++ai)
#pragma unroll
            for (int m = 0; m < 4; ++m) { bf16_t* rowp = O + (size_t)(row0 + ai * HALF + m * 16) * ldc + col0;
#pragma unroll
                for (int bj = 0; bj < 2; ++bj) { const f32x4 v0 = acc[ai][bj][m][0], v1 = acc[ai][bj][m][1];
                    u32x4 w; w.x = pk_bf16(v0[0], v0[1]); w.y = pk_bf16(v0[2], v0[3]); w.z = pk_bf16(v1[0], v1[1]); w.w = pk_bf16(v1[2], v1[3]);
                    *(u32x4*)(rowp + bj * HALF) = w; } }
    }
};

struct EpiProj {
    static constexpr bool PERM = true, AROWPERM = false;
    bf16_t* O; const float* ropeA; const float* ropeR;
    struct Pre {};
    __device__ __forceinline__ Pre prefetch(const Unit&, int, int, int) const { return Pre{}; }
    __device__ __forceinline__ void operator()(f32x4 (&acc)[2][2][4][2], const Unit& u, int wr, int wc, int fr, int fq, const Pre&, LAS unsigned char*) const {
        const int pn = u.pn;
        const int rbase = u.pm * BM + wr * 64 + fr;
        const int cbase = pn * BM + wc * 32 + 8 * fq;
        if (pn <= 4) {
            const float sc = pn < 4 ? 0.125f : 1.0f;
            const bool ropew = (wc & 1) == 0;
#pragma unroll
            for (int ai = 0; ai < 2; ++ai)
#pragma unroll
                for (int m = 0; m < 4; ++m) {
                    const int row = rbase + ai * HALF + m * 16;
                    if (ropew) {
                        const f32x4* tp = (const f32x4*)(ropeA + (size_t)row * 16);
                        const f32x4 cs[2] = {tp[0], tp[1]}; const f32x4 sn[2] = {tp[2], tp[3]};
#pragma unroll
                        for (int bj = 0; bj < 2; ++bj)
#pragma unroll
                            for (int n = 0; n < 2; ++n)
#pragma unroll
                                for (int j = 0; j < 4; ++j) {
                                    const float own = acc[ai][bj][m][n][j]; const float par = __shfl_xor(own, 16);
                                    const float c = cs[n][j], s = sn[n][j];
                                    const float r0 = own * c - par * s, r1 = own * c + par * s;
                                    acc[ai][bj][m][n][j] = (fq == 0) ? r0 : ((fq == 1) ? r1 : own);
                                }
                    }
#pragma unroll
                    for (int bj = 0; bj < 2; ++bj) {
                        const f32x4 v0 = acc[ai][bj][m][0] * sc, v1 = acc[ai][bj][m][1] * sc;
                        u32x4 w; w.x = pk_bf16(v0[0], v0[1]); w.y = pk_bf16(v0[2], v0[3]); w.z = pk_bf16(v1[0], v1[1]); w.w = pk_bf16(v1[2], v1[3]);
                        *(u32x4*)(O + (size_t)row * DIN + cbase + bj * HALF) = w;
                    }
                }
        } else if (pn >= 6 && pn <= 13) {
            const int h = (pn - 6) & 3; const bool isK = pn >= 10;
            const float lg2 = __log2f(1.0f - exp2f(-5.0f - (float)h));
            const int i0 = wc * 32 + 8 * fq;
#pragma unroll
            for (int ai = 0; ai < 2; ++ai)
#pragma unroll
                for (int m = 0; m < 4; ++m) {
                    const int row = rbase + ai * HALF + m * 16;
                    const float p = (float)((row & 127) + 1);
                    const float dec = isK ? 0.0625f * exp2f(-p * lg2) : exp2f(p * lg2);
                    const f32x4* tc = (const f32x4*)(ropeR + (size_t)row * 256 + i0);
                    const f32x4* ts = (const f32x4*)(ropeR + (size_t)row * 256 + 128 + i0);
                    const f32x4 cs[2] = {tc[0], tc[1]}; const f32x4 sn[2] = {ts[0], ts[1]};
#pragma unroll
                    for (int n = 0; n < 2; ++n) {
                        const f32x4 x1 = acc[ai][0][m][n], x2 = acc[ai][1][m][n];
                        acc[ai][0][m][n] = (x1 * cs[n] - x2 * sn[n]) * dec;
                        acc[ai][1][m][n] = (x2 * cs[n] + x1 * sn[n]) * dec;
                    }
#pragma unroll
                    for (int bj = 0; bj < 2; ++bj) {
                        const f32x4 v0 = acc[ai][bj][m][0], v1 = acc[ai][bj][m][1];
                        u32x4 w; w.x = pk_bf16(v0[0], v0[1]); w.y = pk_bf16(v0[2], v0[3]); w.z = pk_bf16(v1[0], v1[1]); w.w = pk_bf16(v1[2], v1[3]);
                        *(u32x4*)(O + (size_t)row * DIN + cbase + bj * HALF) = w;
                    }
                }
        } else {
            const bool gate = pn >= 18;
#pragma unroll
            for (int ai = 0; ai < 2; ++ai)
#pragma unroll
                for (int m = 0; m < 4; ++m) {
                    const int row = rbase + ai * HALF + m * 16;
#pragma unroll
                    for (int bj = 0; bj < 2; ++bj) {
                        f32x4 v0 = acc[ai][bj][m][0], v1 = acc[ai][bj][m][1];
                        if (gate) {
#pragma unroll
                            for (int j = 0; j < 4; ++j) { v0[j] = silu_f(v0[j]); v1[j] = silu_f(v1[j]); }
                        }
                        u32x4 w; w.x = pk_bf16(v0[0], v0[1]); w.y = pk_bf16(v0[2], v0[3]); w.z = pk_bf16(v1[0], v1[1]); w.w = pk_bf16(v1[2], v1[3]);
                        *(u32x4*)(O + (size_t)row * DIN + cbase + bj * HALF) = w;
                    }
                }
        }
    }
};

struct EpiUpConv {
    static constexpr bool PERM = true, AROWPERM = true;
    bf16_t* ACT; float* EDGE; const float* cw; const float* cb; const float* RS;
    struct Pre { f32x4 c, r0, r1; };
    __device__ __forceinline__ Pre prefetch(const Unit& u, int wr, int wc, int lane) const {
        const int k = lane >> 4, part = (lane >> 3) & 1, c = 4 * (lane & 7);
        const float* p = (k < 3 ? cw + (size_t)k * NUP : cb) + part * DFF + u.pn * 128 + wc * 32 + c;
        const float* r = RS + u.pm * BM + wr * HALF + 8 * (lane & 15);
        Pre P; P.c = *(const f32x4*)p; P.r0 = *(const f32x4*)r; P.r1 = *(const f32x4*)(r + 4); return P;
    }
    __device__ __forceinline__ void operator()(f32x4 (&acc)[2][2][4][2], const Unit& u, int wr, int wc, int fr, int fq, const Pre& pre, LAS unsigned char* lds) const {
        const int lane = fq * 16 + fr;
        LAS float* wl = (LAS float*)(lds + STAGE_BYTES + (wr * 4 + wc) * 1024);
        *(LAS f32x4*)(wl + 4 * lane) = pre.c;
#pragma unroll
        for (int gi = 0; gi < 8; ++gi) { const float rsv = gi < 4 ? pre.r0[gi & 3] : pre.r1[gi & 3];
#pragma unroll
            for (int bj = 0; bj < 2; ++bj)
#pragma unroll
                for (int n = 0; n < 2; ++n) acc[gi >> 2][bj][gi & 3][n] *= rsv; }
        const int rowh = u.pm * BM + wr * HALF;
        const int hidx = rowh >> 7;
#pragma unroll
        for (int n = 0; n < 2; ++n) {
            const int ca = u.pn * 128 + wc * 32 + 8 * fq + 4 * n;
            const LAS float* wq = wl + 8 * fq + 4 * n;
            const f32x4 wa0 = *(const LAS f32x4*)(wq), wa1 = *(const LAS f32x4*)(wq + 64), wa2 = *(const LAS f32x4*)(wq + 128), ba = *(const LAS f32x4*)(wq + 192);
            const f32x4 wg0 = *(const LAS f32x4*)(wq + 32), wg1 = *(const LAS f32x4*)(wq + 96), wg2 = *(const LAS f32x4*)(wq + 160), bg = *(const LAS f32x4*)(wq + 224);
            const f32x4 a6 = acc[1][0][2][n], a7 = acc[1][0][3][n], g6 = acc[1][1][2][n], g7 = acc[1][1][3][n];
            f32x4 pa6, pa7, pg6, pg7;
#pragma unroll
            for (int j = 0; j < 4; ++j) { pa6[j] = dpp_ror<0x121>(a6[j]); pa7[j] = dpp_ror<0x121>(a7[j]); pg6[j] = dpp_ror<0x121>(g6[j]); pg7[j] = dpp_ror<0x121>(g7[j]); }
#pragma unroll
            for (int gi = 0; gi < 8; ++gi) {
                const f32x4 a = acc[gi >> 2][0][gi & 3][n], g = acc[gi >> 2][1][gi & 3][n];
                const f32x4 am1 = gi >= 1 ? acc[(gi - 1 + 8) % 8 >> 2][0][(gi - 1 + 8) % 8 & 3][n] : pa7;
                const f32x4 gm1 = gi >= 1 ? acc[(gi - 1 + 8) % 8 >> 2][1][(gi - 1 + 8) % 8 & 3][n] : pg7;
                const f32x4 am2 = gi >= 2 ? acc[(gi - 2 + 8) % 8 >> 2][0][(gi - 2 + 8) % 8 & 3][n] : (gi == 1 ? pa7 : pa6);
                const f32x4 gm2 = gi >= 2 ? acc[(gi - 2 + 8) % 8 >> 2][1][(gi - 2 + 8) % 8 & 3][n] : (gi == 1 ? pg7 : pg6);
                const f32x4 ua = wa0 * am2 + wa1 * am1 + wa2 * a + ba;
                const f32x4 ug = wg0 * gm2 + wg1 * gm1 + wg2 * g + bg;
                const int row = rowh + 8 * fr + gi;
                if (!(gi < 2 && fr == 0)) {
                    u32x2 w; w.x = pk_bf16(gelu_tanh(ua[0]) * ug[0], gelu_tanh(ua[1]) * ug[1]); w.y = pk_bf16(gelu_tanh(ua[2]) * ug[2], gelu_tanh(ua[3]) * ug[3]);
                    *(u32x2*)(ACT + (size_t)row * DFF + ca) = w;
                }
                if (gi < 2 && fr == 0) { float* e = EDGE + (size_t)(hidx * 4 + gi) * NUP; *(f32x4*)(e + ca) = a; *(f32x4*)(e + DFF + ca) = g; }
                if (gi >= 6 && fr == 15) { float* e = EDGE + (size_t)(hidx * 4 + gi - 4) * NUP; *(f32x4*)(e + ca) = a; *(f32x4*)(e + DFF + ca) = g; }
            }
        }
    }
};
}

typedef const Args __attribute__((address_space(4)))* KArgs;
struct Frame {
    LAS unsigned char* lds;
    int tid, lane, wave, G, bid;
    KArgs ka;
    GAS unsigned char* ws;
};
#define WSP(T, off) ((T*)(F.ws + (off)))
#define P_WinT  WSP(bf16_t, WS_WIN)
#define P_WoutT WSP(bf16_t, WS_WOUT)
#define P_WupT  WSP(bf16_t, WS_WUP)
#define P_WdnT  WSP(bf16_t, WS_WDN)
#define P_XN    WSP(bf16_t, WS_XN)
#define P_RS    WSP(float, 65536)
#define P_PROJ  WSP(bf16_t, WS_BIG)
#define P_ACT   WSP(bf16_t, WS_BIG)
#define P_MIX   WSP(float, WS_BIG)
#define P_MIXB  WSP(bf16_t, WS_BIG)
#define P_MIX2B WSP(bf16_t, WS_MIXIN)
#define P_MIXIN WSP(bf16_t, WS_MIXIN)
#define P_MIX2  WSP(float, WS_MIXIN)
#define P_YARAW WSP(bf16_t, WS_YARAW)
#define P_STATE WSP(bf16_t, WS_STATE)
#define P_ROPEA WSP(float, WS_ROPEA)
#define P_ROPER WSP(float, WS_ROPER)
#define P_EDGE  WSP(float, WS_EDGE)
#define P_XR    WSP(bf16_t, WS_XR)

__device__ __forceinline__ void transpose_item(const float* W, int K, int N, bf16_t* WT, int k0, int n0, int drow0, LAS float* scr, int lane, const float* gain = nullptr) {
    const float gl = gain ? gain[k0 + lane] : 1.0f;
#pragma unroll 8
    for (int i = 0; i < 64; ++i) scr[i * 65 + lane] = W[(size_t)(k0 + i) * N + n0 + lane] * __builtin_bit_cast(float, __builtin_amdgcn_readlane(__builtin_bit_cast(int, gl), i));
    asm volatile("s_waitcnt lgkmcnt(0)" ::: "memory");
    const int c = lane & 7;
#pragma unroll
    for (int j = 0; j < 8; ++j) { const int n = (lane >> 3) + 8 * j; const LAS float* s = scr + (8 * c) * 65 + n;
        u32x4 o; o.x = pk_bf16(s[0 * 65], s[1 * 65]); o.y = pk_bf16(s[2 * 65], s[3 * 65]); o.z = pk_bf16(s[4 * 65], s[5 * 65]); o.w = pk_bf16(s[6 * 65], s[7 * 65]);
        *(u32x4*)(WT + (size_t)(drow0 + n) * K + k0 + 8 * c) = o; }
    asm volatile("s_waitcnt lgkmcnt(0)" ::: "memory");
}
__device__ __forceinline__ void p0_prologue(Frame& F) {
    LAS float* scr = (LAS float*)(F.lds + F.wave * 16640);
    const int gw = F.bid * NWAVES + F.wave, NGW = F.G * NWAVES;
    constexpr int I_IN = (DM / 64) * (DIN / 64), I_OUT = (DM / 64) * (DM / 64), I_UP = (DM / 64) * (NUP / 64), I_DN = (DFF / 64) * (DM / 64);
    constexpr int PER_L = I_IN + I_OUT + I_UP + I_DN;
    for (int it = gw; it < DEPTH * PER_L; it += NGW) {
        const int l = it / PER_L; int r = it % PER_L;
        if (r < I_IN) { const int nb = DIN / 64, kb = r / nb, n0 = 64 * (r % nb); transpose_item(((const float*)(GAS const float*)F.ka->w_in) + (size_t)l * DM * DIN, DM, DIN, P_WinT + (size_t)l * DIN * DM, 64 * kb, n0, n0, scr, F.lane); continue; } r -= I_IN;
        if (r < I_OUT) { const int nb = DM / 64, kb = r / nb, n0 = 64 * (r % nb); transpose_item(((const float*)(GAS const float*)F.ka->w_out) + (size_t)l * DM * DM, DM, DM, P_WoutT + (size_t)l * DM * DM, 64 * kb, n0, n0, scr, F.lane); continue; } r -= I_OUT;
        if (r < I_UP) { const int nb = NUP / 64, kb = r / nb, n0 = 64 * (r % nb);
            const int bj = n0 >= DFF ? 1 : 0, cc = n0 - bj * DFF, drow = 256 * (cc >> 7) + 128 * bj + (cc & 127);
            transpose_item(((const float*)(GAS const float*)F.ka->w_up) + (size_t)l * DM * NUP, DM, NUP, P_WupT + (size_t)l * NUP * DM, 64 * kb, n0, drow, scr, F.lane, ((const float*)(GAS const float*)F.ka->pre_ffn) + (size_t)l * DM); continue; } r -= I_UP;
        { const int nb = DM / 64, kb = r / nb, n0 = 64 * (r % nb); transpose_item(((const float*)(GAS const float*)F.ka->w_down) + (size_t)l * DFF * DM, DFF, DM, P_WdnT + (size_t)l * DM * DFF, 64 * kb, n0, n0, scr, F.lane); }
    }
    const int gt = F.bid * NTHREADS + F.tid, NGT = F.G * NTHREADS;
    for (int i = gt; i < M * 8; i += NGT) { const int m = i >> 3, f = i & 7;
        const float inv = powf(500000.0f, -(float)f / 8.0f);
        const double rev = (double)((const int*)(GAS const int*)F.ka->pos)[m] * (double)inv * 0.15915494309189535; const float fr = (float)(rev - floor(rev));
        P_ROPEA[(size_t)m * 16 + f] = __builtin_amdgcn_cosf(fr); P_ROPEA[(size_t)m * 16 + 8 + f] = __builtin_amdgcn_sinf(fr); }
    for (int i = gt; i < M * 128; i += NGT) { const int m = i >> 7, f = i & 127;
        const float inv = powf(10000.0f, -(float)f / 128.0f);
        const double rev = (double)((const int*)(GAS const int*)F.ka->pos)[m] * (double)inv * 0.15915494309189535; const float fr = (float)(rev - floor(rev));
        P_ROPER[(size_t)m * 256 + f] = __builtin_amdgcn_cosf(fr); P_ROPER[(size_t)m * 256 + 128 + f] = __builtin_amdgcn_sinf(fr); }
    for (int m = gw; m < M; m += NGW) {
        const f32x4* xr = (const f32x4*)(((const float*)(GAS const float*)F.ka->x) + (size_t)m * DM) + F.lane; f32x4 v[8]; float ss = 0.f;
#pragma unroll
        for (int j = 0; j < 8; ++j) { v[j] = xr[64 * j]; ss += (v[j].x * v[j].x + v[j].y * v[j].y) + (v[j].z * v[j].z + v[j].w * v[j].w); }
        const float rs = rsqrtf(wave_sum(ss) * (1.0f / DM) + EPS);
        u32x2* o = (u32x2*)(P_XN + (size_t)m * DM) + F.lane; const f32x4* wn = (const f32x4*)((const float*)(GAS const float*)F.ka->pre_mix) + F.lane;
#pragma unroll
        for (int j = 0; j < 8; ++j) { const f32x4 w = wn[64 * j]; u32x2 p; p.x = pk_bf16(v[j].x * rs * w.x, v[j].y * rs * w.y); p.y = pk_bf16(v[j].z * rs * w.z, v[j].w * rs * w.w); o[64 * j] = p; }
    }
}

template <bool XI_F32, bool XO_F32>
__device__ __forceinline__ void rowpass(Frame& F, const void* xi_, const bf16_t* mix, const float* wpost, const float* wnext, void* xo_, int do_xn) {
    const int gw = F.bid * NWAVES + F.wave, NGW = F.G * NWAVES;
    u32x4 mv[4]; f32x4 xv[4][2];
    auto ldx = [&](int m, int j, f32x4& a, f32x4& b2) {
        const int c8 = 8 * (F.lane + 64 * j);
        if (XI_F32) { const float* p = (const float*)xi_ + (size_t)m * DM + c8; a = __builtin_nontemporal_load((const f32x4*)p); b2 = __builtin_nontemporal_load((const f32x4*)(p + 4)); }
        else { const u32x4 r = __builtin_nontemporal_load((const u32x4*)((const bf16_t*)xi_ + (size_t)m * DM + c8));
               a = (f32x4){bf_lo(r.x), bf_hi(r.x), bf_lo(r.y), bf_hi(r.y)}; b2 = (f32x4){bf_lo(r.z), bf_hi(r.z), bf_lo(r.w), bf_hi(r.w)}; }
    };
    f32x4 wpv[4][2], wnv[4][2];
#pragma unroll
    for (int j = 0; j < 4; ++j) { const int c8 = 8 * (F.lane + 64 * j); wpv[j][0] = *(const f32x4*)(wpost + c8); wpv[j][1] = *(const f32x4*)(wpost + c8 + 4); wnv[j][0] = *(const f32x4*)(wnext + c8); wnv[j][1] = *(const f32x4*)(wnext + c8 + 4); }
    int m = gw;
    if (m < M) {
#pragma unroll
        for (int j = 0; j < 4; ++j) { mv[j] = __builtin_nontemporal_load((const u32x4*)(mix + (size_t)m * DM + 8 * (F.lane + 64 * j))); ldx(m, j, xv[j][0], xv[j][1]); }
    }
    while (m < M) {
        const int mn = m + NGW;
        u32x4 nmv[4]; f32x4 nxv[4][2];
        if (mn < M) {
#pragma unroll
            for (int j = 0; j < 4; ++j) { nmv[j] = __builtin_nontemporal_load((const u32x4*)(mix + (size_t)mn * DM + 8 * (F.lane + 64 * j))); ldx(mn, j, nxv[j][0], nxv[j][1]); }
        } else {
#pragma unroll
            for (int j = 0; j < 4; ++j) { nmv[j] = mv[j]; nxv[j][0] = xv[j][0]; nxv[j][1] = xv[j][1]; }
        }
        f32x4 v[4][2]; float ss = 0.f;
#pragma unroll
        for (int j = 0; j < 4; ++j) {
            v[j][0] = (f32x4){bf_lo(mv[j].x), bf_hi(mv[j].x), bf_lo(mv[j].y), bf_hi(mv[j].y)}; v[j][1] = (f32x4){bf_lo(mv[j].z), bf_hi(mv[j].z), bf_lo(mv[j].w), bf_hi(mv[j].w)};
#pragma unroll
            for (int q = 0; q < 2; ++q) ss += (v[j][q].x * v[j][q].x + v[j][q].y * v[j][q].y) + (v[j][q].z * v[j][q].z + v[j][q].w * v[j][q].w);
        }
        const float rs = rsqrtf(wave_sum(ss) * (1.0f / DM) + EPS);
        float s2 = 0.f;
#pragma unroll
        for (int j = 0; j < 4; ++j) { const int c8 = 8 * (F.lane + 64 * j);
#pragma unroll
            for (int q = 0; q < 2; ++q) { const f32x4 y = xv[j][q] + v[j][q] * rs * wpv[j][q]; v[j][q] = y;
                s2 += (y.x * y.x + y.y * y.y) + (y.z * y.z + y.w * y.w); }
            if (XO_F32) { float* p = (float*)xo_ + (size_t)m * DM + c8; __builtin_nontemporal_store(v[j][0], (f32x4*)p); __builtin_nontemporal_store(v[j][1], (f32x4*)(p + 4)); }
            else { u32x4 p; p.x = pk_bf16(v[j][0].x, v[j][0].y); p.y = pk_bf16(v[j][0].z, v[j][0].w); p.z = pk_bf16(v[j][1].x, v[j][1].y); p.w = pk_bf16(v[j][1].z, v[j][1].w);
                   *(u32x4*)((bf16_t*)xo_ + (size_t)m * DM + c8) = p; }
        }
        if (do_xn == 2) { const float rs2 = rsqrtf(wave_sum(s2) * (1.0f / DM) + EPS); if (F.lane == 0) P_RS[m] = rs2; }
        if (do_xn == 1) {
            const float rs2 = rsqrtf(wave_sum(s2) * (1.0f / DM) + EPS);
#pragma unroll
            for (int j = 0; j < 4; ++j) { const int c8 = 8 * (F.lane + 64 * j); const f32x4 w0 = wnv[j][0], w1 = wnv[j][1];
                u32x4 p; p.x = pk_bf16(v[j][0].x * rs2 * w0.x, v[j][0].y * rs2 * w0.y); p.y = pk_bf16(v[j][0].z * rs2 * w0.z, v[j][0].w * rs2 * w0.w);
                p.z = pk_bf16(v[j][1].x * rs2 * w1.x, v[j][1].y * rs2 * w1.y); p.w = pk_bf16(v[j][1].z * rs2 * w1.z, v[j][1].w * rs2 * w1.w);
                *(u32x4*)(P_XN + (size_t)m * DM + c8) = p; }
        }
#pragma unroll
        for (int j = 0; j < 4; ++j) { mv[j] = nmv[j]; xv[j][0] = nxv[j][0]; xv[j][1] = nxv[j][1]; }
        m = mn;
    }
}

typedef short v4i16_t __attribute__((ext_vector_type(4)));
__device__ __forceinline__ s16x4 vtr(const LAS unsigned char* p) { return __builtin_bit_cast(s16x4, __builtin_amdgcn_ds_read_tr16_b64_v4i16((LAS v4i16_t*)p)); }
__device__ __forceinline__ bf16x8 vtr8(const LAS unsigned char* lo, const LAS unsigned char* hi) { const s16x4 a = vtr(lo), b = vtr(hi); return __builtin_shufflevector(a, b, 0, 1, 2, 3, 4, 5, 6, 7); }

constexpr int AT_KPB = 144, AT_VPB = 192;
constexpr int AT_V_OFF = 256 * AT_KPB;
__device__ __forceinline__ void attn_load(Frame& F, int unit, u32x4 (&kv)[4], u32x4 (&vv)[4]) {
    const int b = unit >> 7, nb = (unit >> 2) & 31, kvh = unit & 3;
    const int tokc = b * SEQ + nb * 128;
#pragma unroll
    for (int i = 0; i < 4; ++i) {
        const int p = F.tid + NTHREADS * i, row = p >> 3, ch = p & 7;
        const bool valid = (nb > 0) || (row >= 128);
        kv[i] = (u32x4){0u, 0u, 0u, 0u}; vv[i] = (u32x4){0u, 0u, 0u, 0u};
        if (valid) { const bf16_t* src = P_PROJ + (size_t)(tokc - 128 + row) * DIN + 64 * kvh + 8 * ch; kv[i] = *(const u32x4*)(src + C_KA); vv[i] = *(const u32x4*)(src + C_VA); }
    }
}
__device__ __forceinline__ void attn_qload(Frame& F, int unit, int pp, int lane, bf16x8 (&Q)[4]) {
    const int b = unit >> 7, nb = (unit >> 2) & 31, kvh = unit & 3, pass = F.wave + 8 * pp, g = pass >> 2, c = pass & 3, hq = 4 * kvh + g;
    const bf16_t* qp = P_PROJ + (size_t)(b * SEQ + nb * 128 + 32 * c + (lane & 31)) * DIN + C_QA + 64 * hq + 8 * (lane >> 5);
#pragma unroll
    for (int ks = 0; ks < 4; ++ks) Q[ks] = *(const bf16x8*)(qp + 16 * ks);
}
__device__ __forceinline__ void attn_units(Frame& F, int l, int first, int stride) {
    LAS unsigned char* Ks = F.lds; LAS unsigned char* Vs = F.lds + AT_V_OFF;
    u32x4 kv[4], vv[4]; bf16x8 Qn[4];
    if (first < 512) { attn_load(F, first, kv, vv); attn_qload(F, first, 0, F.lane, Qn); }
#pragma unroll 1
  for (int unit = first; unit < 512; unit += stride) {
    int lane_ = F.lane; asm volatile("" : "+v"(lane_));
    const int lane = lane_, r32 = lane & 31, h2 = lane >> 5, tid = F.wave * 64 + lane;
    const int trq = (lane & 15) >> 2, trc = 16 * ((lane >> 4) & 1) + 4 * (lane & 3);
    const int b = unit >> 7, nb = (unit >> 2) & 31, kvh = unit & 3;
    const int tokc = b * SEQ + nb * 128;
    __syncthreads();
#pragma unroll
    for (int i = 0; i < 4; ++i) {
        const int p = tid + NTHREADS * i, row = p >> 3, ch = p & 7;
        *(LAS u32x4*)(Ks + row * AT_KPB + 16 * ch) = kv[i];
        *(LAS u32x4*)(Vs + row * AT_VPB + 16 * ch) = vv[i];
    }
    __syncthreads();
#pragma unroll 1
    for (int pp = 0; pp < 2; ++pp) {
        const int pass = F.wave + 8 * pp, g = pass >> 2, c = pass & 3, hq = 4 * kvh + g;
        const int qrow = tokc + 32 * c + r32;
        bf16x8 Qf[4];
#pragma unroll
        for (int ks = 0; ks < 4; ++ks) Qf[ks] = Qn[ks];
        if (pp == 0) { attn_qload(F, unit, 1, lane, Qn); if (unit + stride < 512) attn_load(F, unit + stride, kv, vv); }
        else if (unit + stride < 512) attn_qload(F, unit + stride, 0, lane, Qn);
        f32x16 s[5];
#pragma unroll
        for (int t = 0; t < 5; ++t) {
#pragma unroll
            for (int r = 0; r < 16; ++r) s[t][r] = 0.f;
#pragma unroll
            for (int ks = 0; ks < 4; ++ks) { const bf16x8 kf = *(const LAS bf16x8*)(Ks + (32 * (c + t) + r32) * AT_KPB + (16 * ks + 8 * h2) * 2); s[t] = MFMA32(kf, Qf[ks], s[t]); }
            __builtin_amdgcn_sched_barrier(0);
        }
        const float sink = ((const float*)(GAS const float*)F.ka->sinks)[l * 16 + hq];
        float mx = sink;
#pragma unroll
        for (int t = 0; t < 5; ++t) {
            const bool tile_ok = (nb > 0) || (c + t >= 4);
#pragma unroll
            for (int r = 0; r < 16; ++r) {
                float v = s[t][r];
                if (t == 0) v = (crow(r, h2) > r32) ? v : -1e30f;
                if (t == 4) v = (crow(r, h2) <= r32) ? v : -1e30f;
                v = tile_ok ? v : -1e30f;
                s[t][r] = v; mx = fmaxf(mx, v);
            }
        }
        mx = fmaxf(mx, __shfl_xor(mx, 32));
        float sum = 0.f;
#pragma unroll
        for (int t = 0; t < 5; ++t)
#pragma unroll
            for (int r = 0; r < 16; ++r) { const float p = __expf(s[t][r] - mx); s[t][r] = p; sum += p; }
        sum += __shfl_xor(sum, 32);
        __builtin_amdgcn_sched_barrier(0);
        const float inv = 1.0f / (sum + __expf(sink - mx));
        f32x16 o[2];
#pragma unroll
        for (int db = 0; db < 2; ++db)
#pragma unroll
            for (int r = 0; r < 16; ++r) o[db][r] = 0.f;
#pragma unroll
        for (int t = 0; t < 5; ++t) {
#pragma unroll
            for (int r = 0; r < 16; ++r) s[t][r] *= inv;
#pragma unroll
            for (int sk = 0; sk < 2; ++sk) {
                const bf16x8 pb = pack8(s[t], sk);
#pragma unroll
                for (int db = 0; db < 2; ++db) {
                    const LAS unsigned char* vp = Vs + (32 * (c + t) + 16 * sk + 4 * h2 + trq) * AT_VPB + (32 * db + trc) * 2;
                    const bf16x8 va = vtr8(vp, vp + 8 * AT_VPB);
                    o[db] = MFMA32(va, pb, o[db]);
                }
            }
            __builtin_amdgcn_sched_barrier(0);
        }
#pragma unroll
        for (int db = 0; db < 2; ++db)
#pragma unroll
            for (int rq = 0; rq < 4; ++rq) { const int d0 = 32 * db + 8 * rq + 4 * h2;
                u32x2 w; w.x = pk_bf16(o[db][4 * rq], o[db][4 * rq + 1]); w.y = pk_bf16(o[db][4 * rq + 2], o[db][4 * rq + 3]);
                *(u32x2*)(P_YARAW + (size_t)qrow * 1024 + 64 * hq + d0) = w; }
    }
  }
}

constexpr int RS_KPB = 320, RS_VPB = 192;
constexpr int RS_V_OFF = 128 * RS_KPB;
__device__ __forceinline__ void ret_scan_task(Frame& F, int task) {
    const int b = task >> 5, h = (task >> 3) & 3, ep = (task >> 1) & 3, dh = task & 1;
    LAS unsigned char* Kt = F.lds; LAS unsigned char* Vs = F.lds + RS_V_OFF;
    const int w = F.wave, es = w >> 2, db = w & 3;
    const float lg2 = __log2f(1.0f - exp2f(-5.0f - (float)h));
    const float g128 = exp2f(128.0f * lg2);
    f32x16 st;
#pragma unroll
    for (int r = 0; r < 16; ++r) st[r] = 0.f;
    u32x4 kA[4], vA[2], kB[4], vB[2];
    const bf16_t* kbase = P_PROJ + (size_t)(b * SEQ) * DIN + C_KR + 256 * h + 128 * dh;
    const bf16_t* vbase = P_PROJ + (size_t)(b * SEQ) * DIN + C_VR + 256 * h + 64 * ep;
#define RS_LOAD(KR, VR, cc) do { const size_t adv_ = (size_t)(128 * (cc)) * DIN; \
        _Pragma("unroll") for (int i = 0; i < 4; ++i) { const int p = tid_ + NTHREADS * i; KR[i] = *(const u32x4*)(kbase + adv_ + (size_t)(p >> 4) * DIN + 8 * (p & 15)); } \
        _Pragma("unroll") for (int i = 0; i < 2; ++i) { const int p = tid_ + NTHREADS * i; VR[i] = *(const u32x4*)(vbase + adv_ + (size_t)(p >> 3) * DIN + 8 * (p & 7)); } } while (0)
#define RS_STEP(KR, VR, cc) do { \
        __syncthreads(); \
        _Pragma("unroll") for (int i = 0; i < 4; ++i) { const int p = tid_ + NTHREADS * i; *(LAS u32x4*)(Kt + (p >> 4) * RS_KPB + 16 * (p & 15)) = KR[i]; } \
        _Pragma("unroll") for (int i = 0; i < 2; ++i) { const int p = tid_ + NTHREADS * i; *(LAS u32x4*)(Vs + (p >> 3) * RS_VPB + 16 * (p & 7)) = VR[i]; } \
        { unsigned char* sp = (unsigned char*)(P_STATE + ((size_t)((b * 4 + h) * 32 + (cc))) * 65536 + (size_t)(64 * ep + 32 * es + r32_) * 256 + 128 * dh + 32 * db) + 16 * h2_; \
          _Pragma("unroll") for (int k = 0; k < 4; k += 2) { \
            unsigned ax = pk_bf16(st[4 * k], st[4 * k + 1]), ay = pk_bf16(st[4 * k + 2], st[4 * k + 3]), bx = pk_bf16(st[4 * k + 4], st[4 * k + 5]), by = pk_bf16(st[4 * k + 6], st[4 * k + 7]); \
            { auto r_ = __builtin_amdgcn_permlane32_swap(ax, bx, false, false); ax = r_[0]; bx = r_[1]; } \
            { auto r_ = __builtin_amdgcn_permlane32_swap(ay, by, false, false); ay = r_[0]; by = r_[1]; } \
            u32x4 o_; o_.x = ax; o_.y = ay; o_.z = bx; o_.w = by; *(u32x4*)(sp + 16 * k) = o_; } } \
        __syncthreads(); \
        if ((cc) + 2 < 32) RS_LOAD(KR, VR, (cc) + 2); \
        _Pragma("unroll") for (int ks = 0; ks < 8; ++ks) { \
            const LAS unsigned char* ap = Kt + (16 * ks + 8 * h2_ + trq_) * RS_KPB + (32 * db + trc_) * 2;        \
            const LAS unsigned char* bp = Vs + (16 * ks + 8 * h2_ + trq_) * RS_VPB + (32 * es + trc_) * 2;        \
            const bf16x8 af = vtr8(ap, ap + 4 * RS_KPB); const bf16x8 bfr = vtr8(bp, bp + 4 * RS_VPB); \
            st = MFMA32(af, bfr, st); } \
        _Pragma("unroll") for (int r = 0; r < 16; ++r) st[r] *= g128; } while (0)
    { const int tid_ = F.tid; RS_LOAD(kA, vA, 0); RS_LOAD(kB, vB, 1); }
#pragma unroll 1
    for (int c = 0; c < 32; c += 2) {
        int tid_ = F.tid; asm volatile("" : "+v"(tid_));
        const int l_ = tid_ & 63, r32_ = l_ & 31, h2_ = l_ >> 5, trq_ = (l_ & 15) >> 2, trc_ = 16 * ((l_ >> 4) & 1) + 4 * (l_ & 3);
        RS_STEP(kA, vA, c); RS_STEP(kB, vB, c + 1);
    }
#undef RS_LOAD
#undef RS_STEP
}

constexpr int RO_KPB = 528, RO_VPB = 576;
constexpr int RO_V_OFF = 128 * RO_KPB;
constexpr int RO_RED_OFF = RO_V_OFF + 128 * RO_VPB;
__device__ __forceinline__ void ret_out_task(Frame& F, int l, int task) {
    const int b = task >> 7, h = (task >> 5) & 3, c = task & 31;
    const int tok0 = b * SEQ + 128 * c;
    LAS unsigned char* Kc = F.lds; LAS unsigned char* Vs = F.lds + RO_V_OFF; LAS float* red = (LAS float*)(F.lds + RO_RED_OFF);
    int lane_ = F.lane; asm volatile("" : "+v"(lane_));
    const int lane = lane_, r32 = lane & 31, h2 = lane >> 5, w = F.wave, ib = w & 3, hv = w >> 2;
    const int trq = (lane & 15) >> 2, trc = 16 * ((lane >> 4) & 1) + 4 * (lane & 3);
    __syncthreads();
    {
        const unsigned char* sg = (const unsigned char*)(P_STATE + ((size_t)((b * 4 + h) * 32 + c)) * 65536);
#pragma unroll 1
        for (int i = 0; i < 16; ++i) {
            const int k = w + 8 * i, row = 2 * k + (lane >> 5), ch = (lane & 31) ^ (row & 31);
            __builtin_amdgcn_global_load_lds((const unsigned*)(sg + (size_t)row * 512 + ch * 16), (LAS unsigned*)(F.lds + k * 1024), 16, 0, 0);
        }
    }
    const bf16_t* qrow = P_PROJ + (size_t)(tok0 + 32 * ib + r32) * DIN + C_QR + 256 * h + 8 * h2;
    bf16x8 Qf[16];
#pragma unroll
    for (int ks = 0; ks < 16; ++ks) Qf[ks] = *(const bf16x8*)(qrow + 16 * ks);
    asm volatile("s_waitcnt vmcnt(0)" ::: "memory");
    __syncthreads();
    __builtin_amdgcn_sched_barrier(0);
    u32x4 kreg[8], vreg[8];
#pragma unroll
    for (int i = 0; i < 8; ++i) { const int p = (w * 64 + lane) + NTHREADS * i, row = p >> 5, ch = p & 31;
        const bf16_t* src = P_PROJ + (size_t)(tok0 + row) * DIN + 256 * h + 8 * ch;
        kreg[i] = *(const u32x4*)(src + C_KR); vreg[i] = *(const u32x4*)(src + C_VR); }
    __builtin_amdgcn_sched_barrier(0);
    f32x16 o[4];
#pragma unroll
    for (int t = 0; t < 4; ++t)
#pragma unroll
        for (int r = 0; r < 16; ++r) o[t][r] = 0.f;
#pragma unroll
    for (int ks = 0; ks < 16; ++ks) {
#pragma unroll
        for (int t = 0; t < 4; ++t) { const bf16x8 sa = *(const LAS bf16x8*)(F.lds + (128 * hv + 32 * t + r32) * 512 + (((2 * ks + h2) ^ r32) * 16)); o[t] = MFMA32(sa, Qf[ks], o[t]); }
        __builtin_amdgcn_sched_barrier(0);
    }
    __builtin_amdgcn_sched_barrier(0);
    __syncthreads();
#pragma unroll
    for (int i = 0; i < 8; ++i) { const int p = (w * 64 + lane) + NTHREADS * i, row = p >> 5, ch = p & 31;
        *(LAS u32x4*)(Kc + row * RO_KPB + 16 * ch) = kreg[i];
        *(LAS u32x4*)(Vs + row * RO_VPB + 16 * ch) = vreg[i]; }
    __syncthreads();
    __builtin_amdgcn_sched_barrier(0);
#pragma unroll
    for (int jb = 0; jb < 4; ++jb) if (jb <= ib) {
        f32x16 sA, sB;
#pragma unroll
        for (int r = 0; r < 16; ++r) { sA[r] = 0.f; sB[r] = 0.f; }
#pragma unroll
        for (int ks = 0; ks < 16; ks += 2) {
            const bf16x8 k0 = *(const LAS bf16x8*)(Kc + (32 * jb + r32) * RO_KPB + (16 * ks + 8 * h2) * 2);
            const bf16x8 k1 = *(const LAS bf16x8*)(Kc + (32 * jb + r32) * RO_KPB + (16 * (ks + 1) + 8 * h2) * 2);
            sA = MFMA32(k0, Qf[ks], sA); sB = MFMA32(k1, Qf[ks + 1], sB);
            __builtin_amdgcn_sched_barrier(0);
        }
#pragma unroll
        for (int r = 0; r < 16; ++r) { sA[r] += sB[r]; if (jb == ib && crow(r, h2) > r32) sA[r] = 0.f; }
#pragma unroll
        for (int sk = 0; sk < 2; ++sk) {
            const bf16x8 pb = pack8(sA, sk);
#pragma unroll
            for (int t = 0; t < 4; ++t) {
                const LAS unsigned char* vp = Vs + (32 * jb + 16 * sk + 4 * h2 + trq) * RO_VPB + (128 * hv + 32 * t + trc) * 2;
                const bf16x8 va = vtr8(vp, vp + 8 * RO_VPB);
                o[t] = MFMA32(va, pb, o[t]);
            }
        }
        __builtin_amdgcn_sched_barrier(0);
    }
    float ss = 0.f;
#pragma unroll
    for (int t = 0; t < 4; ++t)
#pragma unroll
        for (int r = 0; r < 16; ++r) ss += o[t][r] * o[t][r];
    ss += __shfl_xor(ss, 32);
    if (lane < 32) red[w * 32 + lane] = ss;
    __syncthreads();
    const float tot = red[w * 32 + r32] + red[(w ^ 4) * 32 + r32];
    const float rs = rsqrtf(tot * (1.0f / 256.0f) + EPS);
    const int tok = tok0 + 32 * ib + r32;
#pragma unroll
    for (int t = 0; t < 4; ++t)
#pragma unroll
        for (int rq = 0; rq < 4; ++rq) {
            const int dv0 = 128 * hv + 32 * t + 8 * rq + 4 * h2;
            const u32x2 gt = *(const u32x2*)(P_PROJ + (size_t)tok * DIN + C_GR + 256 * h + dv0);
            const f32x4 wn = *(const f32x4*)(((const float*)(GAS const float*)F.ka->ret_norm) + (size_t)l * 1024 + 256 * h + dv0);
            const float y0 = o[t][4 * rq] * rs * wn[0] * bf_lo(gt.x), y1 = o[t][4 * rq + 1] * rs * wn[1] * bf_hi(gt.x);
            const float y2 = o[t][4 * rq + 2] * rs * wn[2] * bf_lo(gt.y), y3 = o[t][4 * rq + 3] * rs * wn[3] * bf_hi(gt.y);
            u32x2 wv; wv.x = pk_bf16(y0, y1); wv.y = pk_bf16(y2, y3);
            *(u32x2*)(P_MIXIN + (size_t)tok * DM + 1024 + 256 * h + dv0) = wv;
        }
}

__device__ __forceinline__ void attn_norm_rows(Frame& F, int l) {
    const int gw = F.bid * NWAVES + F.wave, NGW = F.G * NWAVES;
    const f32x4* wn = (const f32x4*)(((const float*)(GAS const float*)F.ka->attn_norm) + (size_t)l * 1024);
    f32x4 wv[2][2];
#pragma unroll
    for (int j = 0; j < 2; ++j) { const int col = 8 * (F.lane + 64 * j); wv[j][0] = wn[col / 4]; wv[j][1] = wn[col / 4 + 1]; }
    for (int m0 = gw; m0 < M; m0 += 4 * NGW) {
        u32x4 v[4][2];
#pragma unroll
        for (int i = 0; i < 4; ++i) { const int m = m0 + i * NGW; if (m < M) { const u32x4* src = (const u32x4*)(P_YARAW + (size_t)m * 1024) + F.lane; v[i][0] = src[0]; v[i][1] = src[64]; } else { v[i][0] = (u32x4){0u, 0u, 0u, 0u}; v[i][1] = v[i][0]; } }
#pragma unroll
        for (int i = 0; i < 4; ++i) {
            const int m = m0 + i * NGW;
            float f[16]; float ss = 0.f;
#pragma unroll
            for (int j = 0; j < 2; ++j)
#pragma unroll
                for (int q = 0; q < 4; ++q) { f[8 * j + 2 * q] = bf_lo(v[i][j][q]); f[8 * j + 2 * q + 1] = bf_hi(v[i][j][q]); }
#pragma unroll
            for (int q = 0; q < 16; ++q) ss += f[q] * f[q];
            const float rs = rsqrtf(wave_sum(ss) * (1.0f / 1024.0f) + EPS);
            if (m < M) {
#pragma unroll
                for (int j = 0; j < 2; ++j) { const int col = 8 * (F.lane + 64 * j); const f32x4 w0 = wv[j][0], w1 = wv[j][1];
                    u32x4 o; o.x = pk_bf16(f[8 * j] * rs * w0[0], f[8 * j + 1] * rs * w0[1]); o.y = pk_bf16(f[8 * j + 2] * rs * w0[2], f[8 * j + 3] * rs * w0[3]);
                    o.z = pk_bf16(f[8 * j + 4] * rs * w1[0], f[8 * j + 5] * rs * w1[1]); o.w = pk_bf16(f[8 * j + 6] * rs * w1[2], f[8 * j + 7] * rs * w1[3]);
                    *(u32x4*)(P_MIXIN + (size_t)m * DM + col) = o; }
            }
        }
    }
}

__device__ __forceinline__ void conv_fixup(Frame& F, int l) {
    const float* cw = ((const float*)(GAS const float*)F.ka->conv_w) + (size_t)l * 3 * NUP; const float* cb = ((const float*)(GAS const float*)F.ka->conv_b) + (size_t)l * NUP;
    const int gt = F.bid * NTHREADS + F.tid, NGT = F.G * NTHREADS;
    constexpr int CG = DFF / 4;
    for (int idx = gt; idx < 128 * 2 * CG; idx += NGT) {
        const int cg4 = idx % CG, r = (idx / CG) & 1, hi = idx / (2 * CG);
        const int ca = 4 * cg4; const bool hasprev = (hi & 31) != 0;
        const f32x4 z = {0.f, 0.f, 0.f, 0.f};
        const float* e0 = P_EDGE + (size_t)(hi * 4) * NUP; const float* ep = P_EDGE + (size_t)((hi - 1) * 4) * NUP;
        f32x4 a0, a1, a2, g0, g1, g2;
        if (r == 0) {
            a2 = *(const f32x4*)(e0 + ca); g2 = *(const f32x4*)(e0 + DFF + ca);
            a1 = hasprev ? *(const f32x4*)(ep + 3 * NUP + ca) : z; g1 = hasprev ? *(const f32x4*)(ep + 3 * NUP + DFF + ca) : z;
            a0 = hasprev ? *(const f32x4*)(ep + 2 * NUP + ca) : z; g0 = hasprev ? *(const f32x4*)(ep + 2 * NUP + DFF + ca) : z;
        } else {
            a2 = *(const f32x4*)(e0 + NUP + ca); g2 = *(const f32x4*)(e0 + NUP + DFF + ca);
            a1 = *(const f32x4*)(e0 + ca); g1 = *(const f32x4*)(e0 + DFF + ca);
            a0 = hasprev ? *(const f32x4*)(ep + 3 * NUP + ca) : z; g0 = hasprev ? *(const f32x4*)(ep + 3 * NUP + DFF + ca) : z;
        }
        const f32x4 ua = *(const f32x4*)(cw + ca) * a0 + *(const f32x4*)(cw + NUP + ca) * a1 + *(const f32x4*)(cw + 2 * NUP + ca) * a2 + *(const f32x4*)(cb + ca);
        const f32x4 ug = *(const f32x4*)(cw + DFF + ca) * g0 + *(const f32x4*)(cw + NUP + DFF + ca) * g1 + *(const f32x4*)(cw + 2 * NUP + DFF + ca) * g2 + *(const f32x4*)(cb + DFF + ca);
        u32x2 w; w.x = pk_bf16(gelu_tanh(ua[0]) * ug[0], gelu_tanh(ua[1]) * ug[1]); w.y = pk_bf16(gelu_tanh(ua[2]) * ug[2], gelu_tanh(ua[3]) * ug[3]);
        *(u32x2*)(P_ACT + (size_t)(128 * hi + r) * DFF + ca) = w;
    }
}


#define XB_TMO      128
#define XB_XCNT(j)  (256  + 64 * (j))
#define XB_XSUB(j)  (1280 + 64 * (j))
#define XB_XGEN(j)  (2304 + 64 * (j))
#define XB_TOP      3328
#define XB_TOPGEN   3392
#define XCD_BAR_WORDS 3456
#define XB_SPIN_CAP (1u << 18)
__device__ __forceinline__ unsigned xb_ld(unsigned* p)              { return __hip_atomic_load(p, __ATOMIC_RELAXED, __HIP_MEMORY_SCOPE_AGENT); }
__device__ __forceinline__ unsigned xb_add(unsigned* p, unsigned v) { return __hip_atomic_fetch_add(p, v, __ATOMIC_RELAXED, __HIP_MEMORY_SCOPE_AGENT); }
__device__ __forceinline__ unsigned xb_xcc_id() { return (unsigned)__builtin_amdgcn_s_getreg((3 << 11) | 20) & 0xFu; }
#define XB_SPIN(cond, bar) do { unsigned _sp = 0; while (cond) { __builtin_amdgcn_s_sleep(1); \
    if ((++_sp & 255u) == 0u) { if (xb_ld(&(bar)[XB_TMO])) break; if (_sp > XB_SPIN_CAP) { atomicAdd(&(bar)[XB_TMO], 1u); break; } } } } while (0)
struct XcdBarrier { unsigned* bar; unsigned x; volatile LAS unsigned* st; };
__device__ __forceinline__ XcdBarrier xcd_barrier_post(unsigned* bar, volatile LAS unsigned* st) {
    XcdBarrier b; b.bar = bar; b.x = xb_xcc_id(); b.st = st;
    if (threadIdx.x == 0) (void)xb_add(&bar[XB_XCNT(b.x)], 1u);
    return b;
}
__device__ __forceinline__ void xcd_barrier_complete(unsigned* bar, unsigned x, unsigned& nloc, unsigned& nx) {
    const unsigned G = gridDim.x * gridDim.y * gridDim.z;
    unsigned sum, cnt, mine, sp = 0u;
    for (;;) {
        sum = 0u; cnt = 0u; mine = 0u;
#pragma unroll
        for (unsigned j = 0; j < 16; ++j) { const unsigned c = xb_ld(&bar[XB_XCNT(j)]); sum += c; cnt += (c > 0u) ? 1u : 0u; mine = (j == x) ? c : mine; }
        if (sum == G) break;
        __builtin_amdgcn_s_sleep(1);
        if ((++sp & 255u) == 0u) { if (xb_ld(&bar[XB_TMO])) break; if (sp > XB_SPIN_CAP) { atomicAdd(&bar[XB_TMO], 1u); break; } }
    }
    nloc = mine > 0u ? mine : 1u; nx = cnt > 0u ? cnt : 1u;
}
__device__ __forceinline__ void xcd_barrier(const XcdBarrier& b) {
    asm volatile("s_waitcnt vmcnt(0)" ::: "memory");
    __syncthreads();
    if (threadIdx.x == 0) {
        unsigned* bar = b.bar;
        __builtin_amdgcn_s_waitcnt(0);
        unsigned nloc = b.st[0], nx = b.st[1];
        if (nloc == 0u) { xcd_barrier_complete(bar, b.x, nloc, nx); b.st[0] = nloc; b.st[1] = nx; }
        const unsigned old = xb_add(&bar[XB_XSUB(b.x)], 1u);
        const unsigned gen = old / nloc;
        if (old + 1u == (gen + 1u) * nloc) {
            __builtin_amdgcn_fence(__ATOMIC_RELEASE, "agent");
            asm volatile("s_waitcnt vmcnt(0)" ::: "memory");
            const unsigned og = xb_add(&bar[XB_TOP], 1u);
            const unsigned tg = og / nx;
            if (og + 1u == (tg + 1u) * nx) xb_add(&bar[XB_TOPGEN], 1u);
            else XB_SPIN(xb_ld(&bar[XB_TOPGEN]) == tg, bar);
            __builtin_amdgcn_fence(__ATOMIC_ACQUIRE, "agent");
            xb_add(&bar[XB_XGEN(b.x)], 1u);
            asm volatile("s_waitcnt vmcnt(0)" ::: "memory");
        } else {
            XB_SPIN(xb_ld(&bar[XB_XGEN(b.x)]) == gen, bar);
            __builtin_amdgcn_fence(__ATOMIC_ACQUIRE, "agent");
            asm volatile("s_waitcnt vmcnt(0)" ::: "memory");
        }
    }
    __syncthreads();
}
constexpr int LDS_BARW_OFF = LDS_BYTES - 64;

constexpr int NPHASES = 1 + DEPTH * 9;
__global__ void __launch_bounds__(NTHREADS, 2) fwd_kernel(Args args) {
    extern __shared__ __attribute__((aligned(16))) unsigned char lds_raw[];
    Frame F;
    F.lds = (LAS unsigned char*)lds_raw;
    F.tid = threadIdx.x; F.lane = F.tid & 63; F.wave = __builtin_amdgcn_readfirstlane(F.tid >> 6);
    F.G = gridDim.x; F.bid = blockIdx.x; F.ka = (KArgs)__builtin_amdgcn_kernarg_segment_ptr();
    F.ws = (GAS unsigned char*)F.ka->ws;

    if (threadIdx.x < 16) ((LAS unsigned*)(F.lds + LDS_BARW_OFF))[threadIdx.x] = 0u;
    __syncthreads();
    const XcdBarrier xbar = xcd_barrier_post((unsigned*)(GAS unsigned*)F.ka->ws, (volatile LAS unsigned*)(F.lds + LDS_BARW_OFF));
    const int ph_hi = F.ka->ph_hi;
    for (int ph = F.ka->ph_lo; ph < ph_hi; ++ph) {
        { int t_ = threadIdx.x; asm volatile("" : "+v"(t_)); F.tid = t_; F.lane = t_ & 63; F.wave = __builtin_amdgcn_readfirstlane(t_ >> 6);
          int b_ = blockIdx.x; asm volatile("" : "+s"(b_)); F.bid = b_; int g_ = gridDim.x; asm volatile("" : "+s"(g_)); F.G = g_;
          unsigned long long w_ = (unsigned long long)F.ka->ws; asm volatile("" : "+s"(w_)); F.ws = (GAS unsigned char*)w_;
          unsigned l_ = (unsigned)(size_t)lds_raw; asm volatile("" : "+s"(l_)); F.lds = (LAS unsigned char*)(size_t)l_; }
        if (ph == 0) {
            if (DBG_MASK & 1) p0_prologue(F);
        } else {
            const int l = (ph - 1) / 9, sp = (ph - 1) % 9;
            if (sp == 0 && (DBG_MASK & 2)) {
                pg8::Gemm g{P_XN, P_WinT + (size_t)l * DIN * DM, M, DIN, DM}; pg8::StaticOrder S; S.init(M, DIN, F.G, F.bid);
                pg8::EpiProj E{P_PROJ, P_ROPEA, P_ROPER};
                pg8::gemm_phase<pg8::EpiProj>(F.lds, g, S, E, F.tid);
            } else if (sp == 1 && (DBG_MASK & 4)) {
                if (F.G >= 256) {
                    if (F.bid < 128) ret_scan_task(F, F.bid);
                    else attn_units(F, l, F.bid - 128, F.G - 128);
                } else {
                    for (int t = F.bid; t < 128 + 512; t += F.G) { if (t < 128) ret_scan_task(F, t); else attn_units(F, l, t - 128, 512); }
                }
            } else if (sp == 2 && (DBG_MASK & 8)) {
                for (int t = F.bid; t < 512; t += F.G) ret_out_task(F, l, t);
                attn_norm_rows(F, l);
            } else if (sp == 3 && (DBG_MASK & 16)) {
                pg8::Gemm g{P_MIXIN, P_WoutT + (size_t)l * DM * DM, M, DM, DM}; pg8::StaticOrder S; S.init(M, DM, F.G, F.bid);
                pg8::EpiBf16 E{P_MIXB, DM};
                pg8::gemm_phase<pg8::EpiBf16>(F.lds, g, S, E, F.tid);
            } else if (sp == 4 && (DBG_MASK & 32)) {
                if (l == 0) rowpass<true, false>(F, ((const float*)(GAS const float*)F.ka->x), P_MIXB, ((const float*)(GAS const float*)F.ka->post_mix), ((const float*)(GAS const float*)F.ka->pre_ffn), P_XR, 2);
                else rowpass<false, false>(F, P_XR, P_MIXB, ((const float*)(GAS const float*)F.ka->post_mix) + (size_t)l * DM, ((const float*)(GAS const float*)F.ka->pre_ffn) + (size_t)l * DM, P_XR, 2);
            } else if (sp == 5 && (DBG_MASK & 64)) {
                pg8::Gemm g{P_XR, P_WupT + (size_t)l * NUP * DM, M, NUP, DM};   pg8::StaticOrder S; S.init(M, NUP, F.G, F.bid);
                pg8::EpiUpConv E{P_ACT, P_EDGE, ((const float*)(GAS const float*)F.ka->conv_w) + (size_t)l * 3 * NUP, ((const float*)(GAS const float*)F.ka->conv_b) + (size_t)l * NUP, P_RS};
                pg8::gemm_phase<pg8::EpiUpConv>(F.lds, g, S, E, F.tid);
            } else if (sp == 6 && (DBG_MASK & 128)) {
                conv_fixup(F, l);
            } else if (sp == 7 && (DBG_MASK & 256)) {
                pg8::Gemm g{P_ACT, P_WdnT + (size_t)l * DM * DFF, M, DM, DFF}; pg8::StaticOrder S; S.init(M, DM, F.G, F.bid);
                pg8::EpiBf16 E{P_MIX2B, DM};
                pg8::gemm_phase<pg8::EpiBf16>(F.lds, g, S, E, F.tid);
            } else if (sp == 8 && (DBG_MASK & 512)) {
                if (l + 1 < DEPTH) rowpass<false, false>(F, P_XR, P_MIX2B, ((const float*)(GAS const float*)F.ka->post_ffn) + (size_t)l * DM, ((const float*)(GAS const float*)F.ka->pre_mix) + (size_t)(l + 1) * DM, P_XR, 1);
                else rowpass<false, true>(F, P_XR, P_MIX2B, ((const float*)(GAS const float*)F.ka->post_ffn) + (size_t)l * DM, ((const float*)(GAS const float*)F.ka->pre_mix), ((float*)(GAS float*)F.ka->out), 0);
            }
        }
        if (ph + 1 < ph_hi) {
            if (ph_hi > NPHASES) { __syncthreads(); cg::this_grid().sync(); }
            else xcd_barrier(xbar);
        }
    }
}

extern "C" void kernel_launch(void* const* d_in, const int* in_sizes, int n_in, void* d_out, int out_size, void* d_ws, size_t ws_size, hipStream_t stream) {
    static int grid = 0;
    if (grid == 0) {
        if (n_in != 15 || in_sizes[0] != M * DM || out_size != M * DM || ws_size < WS_END) {
            fprintf(stderr, "kernel_launch: unexpected shapes (n_in %d, in0 %d, out %d, ws %zu < %zu)\n", n_in, n_in > 0 ? in_sizes[0] : -1, out_size, ws_size, (size_t)WS_END); grid = -1; return; }
        int dev = 0, cus = 0, per_cu = 0;
        hipGetDevice(&dev); hipDeviceGetAttribute(&cus, hipDeviceAttributeMultiprocessorCount, dev);
        hipFuncSetAttribute((const void*)fwd_kernel, hipFuncAttributeMaxDynamicSharedMemorySize, LDS_BYTES);
        hipOccupancyMaxActiveBlocksPerMultiprocessor(&per_cu, (const void*)fwd_kernel, NTHREADS, LDS_BYTES);
        if (per_cu < 1) per_cu = 1;
        (void)hipGetLastError();
        grid = cus * per_cu;
        if (grid > 256) grid = 256;
    }
    if (grid < 0) return;
    Args a{};
    a.x = (const float*)d_in[0]; a.pos = (const int*)d_in[1]; a.w_in = (const float*)d_in[2]; a.w_out = (const float*)d_in[3]; a.w_up = (const float*)d_in[4];
    a.w_down = (const float*)d_in[5]; a.conv_w = (const float*)d_in[6]; a.conv_b = (const float*)d_in[7]; a.sinks = (const float*)d_in[8];
    a.pre_mix = (const float*)d_in[9]; a.post_mix = (const float*)d_in[10]; a.attn_norm = (const float*)d_in[11]; a.ret_norm = (const float*)d_in[12];
    a.pre_ffn = (const float*)d_in[13]; a.post_ffn = (const float*)d_in[14];
    a.out = (float*)d_out; a.ws = (unsigned char*)d_ws;
#if MK_SINGLE
    hipMemsetAsync(d_ws, 0, 16384, stream);
    a.ph_lo = 0; a.ph_hi = NPHASES;
    void* kargs[] = {&a};
    hipError_t e = hipLaunchCooperativeKernel((const void*)fwd_kernel, dim3(grid), dim3(NTHREADS), kargs, LDS_BYTES, stream);
    if (e != hipSuccess) fprintf(stderr, "cooperative launch failed: %s (grid %d)\n", hipGetErrorString(e), grid);
#else
    for (int ph = 0; ph < NPHASES; ++ph) { a.ph_lo = ph; a.ph_hi = ph + 1; hipLaunchKernelGGL(fwd_kernel, dim3(grid), dim3(NTHREADS), LDS_BYTES, stream, a); }
#endif
}
```
